# Optimizing an MI355X kernel written in HIP

```python
import math
import jax, jax.numpy as jnp
from jax import lax
import numpy as np

D_MODEL = 1024
BATCH = 8
SEQ = 2048
DEPTH = 2
DEC_BATCH = 4
DEC_SEQ = 4096
PAST_LEN = 128

MIX_WIDTH = D_MODEL
HEAD_DIM = 64
DIFF_WIDTH = MIX_WIDTH // 2
DIFF_HEADS = DIFF_WIDTH // (2 * HEAD_DIM)
QK_WIDTH = DIFF_HEADS * 2 * HEAD_DIM
V_WIDTH = DIFF_WIDTH
FOURIER_WIDTH = MIX_WIDTH - DIFF_WIDTH
FOURIER_GROUP_DIM = 64
FOURIER_GROUPS = FOURIER_WIDTH // FOURIER_GROUP_DIM
IN_COLS = 2 * QK_WIDTH + V_WIDTH + FOURIER_WIDTH
D_FF = 2816
NUM_BUCKETS = 32
REL_MAX_DISTANCE = 128
Q_BLOCK = 128
N_MOD = 9
EPS = 1e-6
ATTN_SCALE = HEAD_DIM ** -0.5

kernel_name = "hybrid_diffattn_fnet_macaron_encoder"


def rmsnorm(x, g):
    xf = x.astype(jnp.float32)
    y = xf * lax.rsqrt(jnp.mean(xf * xf, axis=-1, keepdims=True) + EPS)
    return (y * g.astype(jnp.float32)).astype(x.dtype)


def modulate(h, shift, scale):
    return h * (1 + scale[:, None, :]) + shift[:, None, :]


def swiglu(h, wi, wo):
    gu = h @ wi
    g, u = jnp.split(gu, 2, axis=-1)
    return (jax.nn.silu(g) * u) @ wo


def rel_bucket(rel):
    nb = NUM_BUCKETS // 2
    max_exact = nb // 2
    ret = (rel > 0).astype(jnp.int32) * nb
    n = jnp.abs(rel)
    nf = jnp.maximum(n, 1).astype(jnp.float32)
    large = max_exact + (jnp.log(nf / max_exact) / math.log(REL_MAX_DISTANCE / max_exact)
                         * (nb - max_exact)).astype(jnp.int32)
    large = jnp.minimum(large, nb - 1)
    return ret + jnp.where(n < max_exact, n, large)


def diff_attention(q, k, v, lam, rel_bias):
    B, H, _, S, dh = q.shape
    n_blk = S // Q_BLOCK
    q_blocks = q.reshape(B, H, 2, n_blk, Q_BLOCK, dh).transpose(3, 0, 1, 2, 4, 5)
    starts = jnp.arange(n_blk, dtype=jnp.int32) * Q_BLOCK
    kpos = jnp.arange(S, dtype=jnp.int32)

    def block(args):
        qb, start = args
        qpos = start + jnp.arange(Q_BLOCK, dtype=jnp.int32)
        buckets = rel_bucket(kpos[None, :] - qpos[:, None])
        bias = rel_bias[buckets].transpose(2, 3, 0, 1)
        s = jnp.einsum('bhjqd,bhjkd->bhjqk', qb, k).astype(jnp.float32) * ATTN_SCALE
        s = s + bias.astype(jnp.float32)
        p = jax.nn.softmax(s, axis=-1)
        a = p[:, :, 0] - lam * p[:, :, 1]
        return jnp.einsum('bhqk,bhkd->bhqd', a.astype(v.dtype), v)

    o = lax.map(block, (q_blocks, starts))
    return o.transpose(1, 0, 3, 2, 4).reshape(B, S, H, 2 * dh)


def mixer(h, w_in, w_out, q_norm, k_norm, lambda_qk, subln, rel_bias, lambda_init):
    B, S, _ = h.shape
    z = h @ w_in
    q, k, v, f = jnp.split(z, [QK_WIDTH, 2 * QK_WIDTH, 2 * QK_WIDTH + V_WIDTH], axis=-1)
    q = rmsnorm(q.reshape(B, S, DIFF_HEADS, 2, HEAD_DIM), q_norm).transpose(0, 2, 3, 1, 4)
    k = rmsnorm(k.reshape(B, S, DIFF_HEADS, 2, HEAD_DIM), k_norm).transpose(0, 2, 3, 1, 4)
    v = v.reshape(B, S, DIFF_HEADS, 2 * HEAD_DIM).transpose(0, 2, 1, 3)
    lqk = lambda_qk.astype(jnp.float32)
    lam = (jnp.exp(jnp.sum(lqk[0] * lqk[1])) - jnp.exp(jnp.sum(lqk[2] * lqk[3]))
           + lambda_init)
    o = diff_attention(q, k, v, lam, rel_bias)
    o = (rmsnorm(o, subln) * (1.0 - lambda_init)).reshape(B, S, DIFF_WIDTH)
    fg = f.reshape(B, S, FOURIER_GROUPS, FOURIER_GROUP_DIM).astype(jnp.float32)
    fo = jnp.fft.fft2(fg, axes=(1, 3), norm='ortho').real.astype(h.dtype).reshape(B, S, FOURIER_WIDTH)
    return jnp.concatenate([o, fo], axis=-1) @ w_out


def trunk(x, c, ada_w, ada_b, norm_ffn1, norm_mix, norm_ffn2, ffn1_wi, ffn1_wo,
          ffn2_wi, ffn2_wo, w_in, w_out, q_norm, k_norm, lambda_qk, subln, rel_bias):
    sc = jax.nn.silu(c)
    for l in range(DEPTH):
        lambda_init = 0.8 - 0.6 * math.exp(-0.3 * l)
        mod = sc @ ada_w[l] + ada_b[l]
        sh1, s1, g1, sh2, s2, g2, sh3, s3, g3 = jnp.split(mod, N_MOD, axis=-1)
        h = modulate(rmsnorm(x, norm_ffn1[l]), sh1, s1)
        x = x + 0.5 * g1[:, None, :] * swiglu(h, ffn1_wi[l], ffn1_wo[l])
        h = modulate(rmsnorm(x, norm_mix[l]), sh2, s2)
        x = x + g2[:, None, :] * mixer(h, w_in[l], w_out[l], q_norm[l], k_norm[l],
                                       lambda_qk[l], subln[l], rel_bias, lambda_init)
        h = modulate(rmsnorm(x, norm_ffn2[l]), sh3, s3)
        x = x + 0.5 * g3[:, None, :] * swiglu(h, ffn2_wi[l], ffn2_wo[l])
    return x


def setup_inputs(seed: int = 0) -> dict:
    key = jax.random.key(seed)
    ks = jax.random.split(key, 24)
    f32 = jnp.float32
    nrm = lambda k, shape, s: jax.random.normal(k, shape, f32) * s
    gain = lambda k, shape: 1.0 + 0.02 * jax.random.normal(k, shape, f32)
    return {
        "x_prompt": nrm(ks[0], (BATCH, SEQ, D_MODEL), 1.0),
        "x_sample": nrm(ks[1], (DEC_BATCH, DEC_SEQ, D_MODEL), 1.0),
        "c_prompt": nrm(ks[2], (BATCH, D_MODEL), 1.0),
        "c_sample": nrm(ks[3], (DEC_BATCH, D_MODEL), 1.0),
        "ada_w": nrm(ks[4], (DEPTH, D_MODEL, N_MOD * D_MODEL), 0.5 * D_MODEL ** -0.5),
        "ada_b": nrm(ks[5], (DEPTH, N_MOD * D_MODEL), 0.02),
        "norm_ffn1": gain(ks[6], (DEPTH, D_MODEL)),
        "norm_mix": gain(ks[7], (DEPTH, D_MODEL)),
        "norm_ffn2": gain(ks[8], (DEPTH, D_MODEL)),
        "ffn1_wi": nrm(ks[9], (DEPTH, D_MODEL, 2 * D_FF), D_MODEL ** -0.5),
        "ffn1_wo": nrm(ks[10], (DEPTH, D_FF, D_MODEL), D_FF ** -0.5),
        "ffn2_wi": nrm(ks[11], (DEPTH, D_MODEL, 2 * D_FF), D_MODEL ** -0.5),
        "ffn2_wo": nrm(ks[12], (DEPTH, D_FF, D_MODEL), D_FF ** -0.5),
        "w_in": nrm(ks[13], (DEPTH, D_MODEL, IN_COLS), D_MODEL ** -0.5),
        "w_out": nrm(ks[14], (DEPTH, MIX_WIDTH, D_MODEL), MIX_WIDTH ** -0.5),
        "q_norm": gain(ks[15], (DEPTH, HEAD_DIM)),
        "k_norm": gain(ks[16], (DEPTH, HEAD_DIM)),
        "lambda_qk": nrm(ks[17], (DEPTH, 4, HEAD_DIM), 0.1),
        "subln": gain(ks[18], (DEPTH, 2 * HEAD_DIM)),
        "rel_bias": nrm(ks[19], (NUM_BUCKETS, DIFF_HEADS, 2), 0.5),
    }


def reference(x_prompt, x_sample, c_prompt, c_sample, ada_w, ada_b, norm_ffn1, norm_mix,
              norm_ffn2, ffn1_wi, ffn1_wo, ffn2_wi, ffn2_wo, w_in, w_out, q_norm, k_norm,
              lambda_qk, subln, rel_bias):
    y_prompt = trunk(x_prompt, c_prompt, ada_w, ada_b, norm_ffn1, norm_mix, norm_ffn2,
                     ffn1_wi, ffn1_wo, ffn2_wi, ffn2_wo, w_in, w_out, q_norm, k_norm,
                     lambda_qk, subln, rel_bias)
    y_sample = trunk(x_sample, c_sample, ada_w, ada_b, norm_ffn1, norm_mix, norm_ffn2,
                     ffn1_wi, ffn1_wo, ffn2_wi, ffn2_wo, w_in, w_out, q_norm, k_norm,
                     lambda_qk, subln, rel_bias)
    return (y_prompt, y_sample)
```

```cpp
#include <hip/hip_runtime.h>
#include <hip/hip_cooperative_groups.h>
#include <cstdio>
#include <cstdint>
namespace cg = cooperative_groups;
#ifndef REP_P0
#define REP_P0 1
#endif
#ifndef REP_CVT
#define REP_CVT 1
#endif
#ifndef REP_N
#define REP_N 1
#endif
#ifndef REP_G1
#define REP_G1 1
#endif
#ifndef REP_G3
#define REP_G3 1
#endif
#ifndef REP_G2
#define REP_G2 1
#endif
#ifndef REP_SYNC
#define REP_SYNC 1
#endif
#ifndef REP_AT
#define REP_AT 1
#endif

#define LAS __attribute__((address_space(3)))
typedef unsigned short bf16_t;
typedef short bf16x8 __attribute__((ext_vector_type(8)));
typedef float f32x2 __attribute__((ext_vector_type(2)));
typedef float f32x4 __attribute__((ext_vector_type(4)));
typedef float f32x16 __attribute__((ext_vector_type(16)));
typedef unsigned u32x2 __attribute__((ext_vector_type(2)));
typedef unsigned u32x4 __attribute__((ext_vector_type(4)));
typedef __bf16 bf16x2_t __attribute__((ext_vector_type(2)));

constexpr int D = 1024, T = 32768, TP = 16384, FF = 2816, NBATCH = 12;
constexpr int SEQ_P = 2048, SEQ_S = 4096;
constexpr float EPS = 1e-6f;
constexpr float LOG2E = 1.4426950408889634f;
constexpr float QSCALE = 0.125f * LOG2E;

constexpr size_t MiB = 1u << 20;
constexpr size_t WS_CTL = 0, CTL_BYTES = 32768;
constexpr size_t WS_MISC = 64 * 1024;
constexpr size_t WS_BT = 128 * 1024;
constexpr size_t WS_MOD = 1 * MiB;
constexpr size_t WS_WI1 = 2 * MiB;
constexpr size_t WS_WO1 = 13 * MiB;
constexpr size_t WS_WI2 = 19 * MiB;
constexpr size_t WS_WO2 = 30 * MiB;
constexpr size_t WS_WQK = 36 * MiB;
constexpr size_t WS_WVF = 38 * MiB;
constexpr size_t WS_WOUT = 41 * MiB;
constexpr size_t WS_DFT = 43 * MiB;
constexpr size_t WS_XN = 75 * MiB;
constexpr size_t WS_BIG = 139 * MiB;
constexpr size_t WS_Q = WS_BIG, WS_K = WS_BIG + 32 * MiB, WS_VT = WS_BIG + 64 * MiB, WS_FTS = WS_BIG + 96 * MiB, WS_FTP = WS_BIG + 112 * MiB;
constexpr size_t WS_XFC = 283 * MiB, WS_XFS = 315 * MiB;
constexpr size_t WS_NY = 192 * 1024;
constexpr size_t WS_END = 347 * MiB;

__device__ __forceinline__ unsigned pk2(float lo, float hi) { f32x2 v; v.x = lo; v.y = hi; bf16x2_t b = __builtin_convertvector(v, bf16x2_t); return __builtin_bit_cast(unsigned, b); }
__device__ __forceinline__ float shx(float v, int o, int lane) { return __int_as_float(__builtin_amdgcn_ds_bpermute((lane ^ o) << 2, __float_as_int(v))); }
__device__ __forceinline__ float wave_sum(float v, int lane) {
#pragma unroll
    for (int o = 1; o < 64; o <<= 1) v += shx(v, o, lane);
    return v;
}
#define LDS_WAIT() asm volatile("s_waitcnt lgkmcnt(0)" ::: "memory")
__device__ __forceinline__ int opaque(int x) { asm volatile("" : "+v"(x)); return x; }


#define XB_TMO      128
#define XB_XCNT(j)  (256  + 64 * (j))
#define XB_XSUB(j)  (1280 + 64 * (j))
#define XB_XGEN(j)  (2304 + 64 * (j))
#define XB_TOP      3328
#define XB_TOPGEN   3392
#define XCD_BAR_WORDS 3456
#define XB_SPIN_CAP (1u << 22)
__device__ __forceinline__ unsigned xb_ld(unsigned* p)              { return __hip_atomic_load(p, __ATOMIC_RELAXED, __HIP_MEMORY_SCOPE_AGENT); }
__device__ __forceinline__ unsigned xb_add(unsigned* p, unsigned v) { return __hip_atomic_fetch_add(p, v, __ATOMIC_RELAXED, __HIP_MEMORY_SCOPE_AGENT); }
__device__ __forceinline__ unsigned xb_xcc_id() { return (unsigned)__builtin_amdgcn_s_getreg((3 << 11) | 20) & 0xFu; }
#define XB_SPIN(cond, bar) do { unsigned _sp = 0; while (cond) { __builtin_amdgcn_s_sleep(1); \
    if ((++_sp & 255u) == 0u) { if (xb_ld(&(bar)[XB_TMO])) break; if (_sp > XB_SPIN_CAP) { atomicAdd(&(bar)[XB_TMO], 1u); break; } } } } while (0)
struct XcdBarrier { unsigned* bar; unsigned x; volatile LAS unsigned* st; };
__device__ __forceinline__ XcdBarrier xcd_barrier_post(unsigned* bar, volatile LAS unsigned* st) {
    XcdBarrier b; b.bar = bar; b.x = xb_xcc_id(); b.st = st;
    if (threadIdx.x == 0) (void)xb_add(&bar[XB_XCNT(b.x)], 1u);
    return b;
}
__device__ __forceinline__ void xcd_barrier_complete(unsigned* bar, unsigned x, unsigned& nloc, unsigned& nx) {
    const unsigned G = gridDim.x * gridDim.y * gridDim.z;
    unsigned sum, cnt, mine, sp = 0u;
    for (;;) {
        sum = 0u; cnt = 0u; mine = 0u;
#pragma unroll
        for (unsigned j = 0; j < 16; ++j) { const unsigned c = xb_ld(&bar[XB_XCNT(j)]); sum += c; cnt += (c > 0u) ? 1u : 0u; mine = (j == x) ? c : mine; }
        if (sum == G) break;
        __builtin_amdgcn_s_sleep(1);
        if ((++sp & 255u) == 0u) { if (xb_ld(&bar[XB_TMO])) break; if (sp > XB_SPIN_CAP) { atomicAdd(&bar[XB_TMO], 1u); break; } }
    }
    nloc = mine > 0u ? mine : 1u; nx = cnt > 0u ? cnt : 1u;
}
__device__ __forceinline__ void xcd_barrier(const XcdBarrier& b) {
    asm volatile("s_waitcnt vmcnt(0)" ::: "memory");
    __syncthreads();
    if (threadIdx.x == 0) {
        unsigned* bar = b.bar;
        __builtin_amdgcn_s_waitcnt(0);
        unsigned nloc = b.st[0], nx = b.st[1];
        if (nloc == 0u) { xcd_barrier_complete(bar, b.x, nloc, nx); b.st[0] = nloc; b.st[1] = nx; }
        const unsigned old = xb_add(&bar[XB_XSUB(b.x)], 1u);
        const unsigned gen = old / nloc;
        if (old + 1u == (gen + 1u) * nloc) {
            __builtin_amdgcn_fence(__ATOMIC_RELEASE, "agent");
            asm volatile("s_waitcnt vmcnt(0)" ::: "memory");
            const unsigned og = xb_add(&bar[XB_TOP], 1u);
            const unsigned tg = og / nx;
            if (og + 1u == (tg + 1u) * nx) xb_add(&bar[XB_TOPGEN], 1u);
            else XB_SPIN(xb_ld(&bar[XB_TOPGEN]) == tg, bar);
            __builtin_amdgcn_fence(__ATOMIC_ACQUIRE, "agent");
            xb_add(&bar[XB_XGEN(b.x)], 1u);
            asm volatile("s_waitcnt vmcnt(0)" ::: "memory");
        } else {
            XB_SPIN(xb_ld(&bar[XB_XGEN(b.x)]) == gen, bar);
            __builtin_amdgcn_fence(__ATOMIC_ACQUIRE, "agent");
            asm volatile("s_waitcnt vmcnt(0)" ::: "memory");
        }
    }
    __syncthreads();
}

namespace pg8 {
constexpr int BM = 256, BK = 64, HALF = 128, HTB = HALF * BK * 2, STAGE_BYTES = 8 * HTB, NXCD = 8, WGM = 8;
__host__ __device__ __forceinline__ int lds_byte(int r, int c) { const int st = (r >> 4) * 2 + (c >> 5), rr = r & 15, cc = c & 31, ob = rr * 64 + cc * 2; return st * 1024 + (ob ^ (((ob >> 9) & 1) << 5)); }
__host__ __device__ __forceinline__ void stage_rc(int b, int& R, int& C) { const int st = b / 1024, sb = b % 1024, swz = sb ^ (((sb >> 9) & 1) << 5); R = (st >> 1) * 16 + swz / 64; C = (st & 1) * 32 + (swz % 64) / 2; }
__host__ __device__ __forceinline__ int perm32(int rho) { const int n = rho >> 4, i = rho & 15; return 8 * (i >> 2) + 4 * n + (i & 3); }

struct Unit { int pm, pn; };
struct Gemm { const bf16_t* A; const bf16_t* Bt; int lda, ldb, K; };

struct StaticOrder {
    int nM, nN, nwg, G, c;
    __device__ void init(int M, int N, int G_, int c_) { nM = M / BM; nN = N / BM; nwg = nM * nN; G = G_; c = c_; }
    __device__ bool next(int i, Unit& u) const {
        const long L = (long)i * G + c; if (L >= nwg) return false;
        int wgid = (int)L; { const int q = nwg / NXCD, r = nwg % NXCD, xcd = wgid % NXCD, off = wgid / NXCD; wgid = (xcd < r ? xcd * (q + 1) : r * (q + 1) + (xcd - r) * q) + off; }
        const int nig = WGM * nN, gid = wgid / nig, fm = gid * WGM, gsz = (nM - fm) < WGM ? (nM - fm) : WGM;
        u.pm = fm + ((wgid % nig) % gsz); u.pn = (wgid % nig) / gsz; return true;
    }
};
struct FoldOrder {
    int G, c;
    __device__ bool next(int i, Unit& u) const { const int L = i * G + c; if (L >= 256) return false; const int part = L >> 7, w = L & 127; u.pm = part * 2 + (w & 1); u.pn = part * 64 + (w >> 1); return true; }
};
struct OneUnit { __device__ bool next(int i, Unit& u) const { if (i > 0) return false; u.pm = 0; u.pn = 0; return true; } };

typedef f32x4 Acc[2][2][4][2];

template <class Epi, class Sched>
__device__ __forceinline__ void gemm_phase(LAS unsigned char* lds, const Gemm g, const Sched& S, const Epi& E) {
    const int tid = opaque((int)threadIdx.x), wid = __builtin_amdgcn_readfirstlane(tid >> 6), lane = tid & 63, wr = wid >> 2, wc = wid & 3, fr = lane & 15, fq = lane >> 4;
    const int K = g.K, nt = K / BK;
    unsigned voffA[2], voffB[2];
#pragma unroll
    for (int i = 0; i < 2; ++i) { int R, C; stage_rc(tid * 16 + i * 8192, R, C); const int Rb = Epi::PERM ? ((R & ~31) + perm32(R & 31)) : R;
        voffA[i] = (unsigned)(R * g.lda + C) * 2u; voffB[i] = (unsigned)(Rb * g.ldb + C) * 2u; }
    const size_t kstep = (size_t)(BK * 2);
    const size_t hstepA = (size_t)HALF * g.lda * 2, hstepB = (size_t)HALF * g.ldb * 2;
    const size_t tstepA = 2 * hstepA, tstepB = 2 * hstepB;
    const unsigned ldsw = (unsigned)wid * 1024u;
    const int aoff = lds_byte(wr * 64 + fr, fq * 8), boff = lds_byte(wc * 32 + fr, fq * 8);
#define PG8_SA(b, h) (((b) * 2 + (h)) * HTB)
#define PG8_SB(b, h) ((4 + (b) * 2 + (h)) * HTB)
#define PG8_STAGE(bufoff, gbase, voff) do { _Pragma("unroll") for (int _i = 0; _i < 2; ++_i) \
        __builtin_amdgcn_global_load_lds((const unsigned*)((const char*)(gbase) + (voff)[_i]), (LAS unsigned*)(lds + (bufoff) + ldsw + _i * 8192), 16, 0, 0); } while (0)
#define PG8_LDA(dst, b, h) do { _Pragma("unroll") for (int m = 0; m < 4; ++m) _Pragma("unroll") for (int k = 0; k < 2; ++k) dst[m][k] = *(const LAS bf16x8*)(lds + PG8_SA(b, h) + aoff + m * 2048 + k * 1024); } while (0)
#define PG8_LDB(dst, b, h) do { _Pragma("unroll") for (int n = 0; n < 2; ++n) _Pragma("unroll") for (int k = 0; k < 2; ++k) dst[n][k] = *(const LAS bf16x8*)(lds + PG8_SB(b, h) + boff + n * 2048 + k * 1024); } while (0)
#define PG8_MMA(ai, bj, At, Bt) do { __builtin_amdgcn_s_setprio(1); _Pragma("unroll") for (int m = 0; m < 4; ++m) _Pragma("unroll") for (int n = 0; n < 2; ++n) _Pragma("unroll") for (int k = 0; k < 2; ++k) \
        acc[ai][bj][m][n] = __builtin_amdgcn_mfma_f32_16x16x32_bf16(Bt[n][k], At[m][k], acc[ai][bj][m][n], 0, 0, 0); __builtin_amdgcn_s_setprio(0); } while (0)
#define PG8_WAIT_V(n) asm volatile("s_waitcnt vmcnt(" #n ")" ::: "memory")
#define PG8_WAIT_L(n) asm volatile("s_waitcnt lgkmcnt(" #n ")" ::: "memory")
#define PG8_BAR __builtin_amdgcn_s_barrier()
#define PG8_SCHED __builtin_amdgcn_sched_barrier(0)
    Unit cur, nxt; int ui = 0;
    if (!S.next(0, cur)) return;
    f32x4 acc[2][2][4][2];
#pragma unroll
    for (int a = 0; a < 2; ++a)
#pragma unroll
        for (int b = 0; b < 2; ++b)
#pragma unroll
            for (int m = 0; m < 4; ++m)
#pragma unroll
                for (int n = 0; n < 2; ++n) acc[a][b][m][n] = (f32x4){0.f, 0.f, 0.f, 0.f};
    bf16x8 At[4][2], B0[2][2], B1[2][2];
    const char* cA = (const char*)g.A + (size_t)cur.pm * tstepA; const char* cB = (const char*)g.Bt + (size_t)cur.pn * tstepB;
    PG8_STAGE(PG8_SB(0, 0), cB, voffB); PG8_STAGE(PG8_SB(0, 1), cB + hstepB, voffB); PG8_STAGE(PG8_SA(0, 0), cA, voffA); PG8_STAGE(PG8_SA(0, 1), cA + hstepA, voffA);
    if (wr == 1) PG8_BAR;
    PG8_WAIT_V(2); PG8_BAR;
    PG8_STAGE(PG8_SB(1, 0), cB + kstep, voffB); PG8_STAGE(PG8_SA(1, 0), cA + kstep, voffA); PG8_STAGE(PG8_SB(1, 1), cB + hstepB + kstep, voffB);
    PG8_WAIT_V(6); PG8_BAR;
    for (;;) {
        const bool has_next = S.next(ui + 1, nxt);
        const char* nA = has_next ? (const char*)g.A + (size_t)nxt.pm * tstepA : cA; const char* nB = has_next ? (const char*)g.Bt + (size_t)nxt.pn * tstepB : cB;
        for (int t = 0; t < nt; t += 2) {
            const bool last = (t == nt - 2);
            const char* a1 = cA + (size_t)(t + 1) * kstep;
            const char* a2 = last ? nA : cA + (size_t)(t + 2) * kstep; const char* b2 = last ? nB : cB + (size_t)(t + 2) * kstep;
            const char* a3 = a2 + kstep; const char* b3 = b2 + kstep;
            PG8_LDB(B0, 0, 0); PG8_LDB(B1, 0, 1); PG8_SCHED; PG8_LDA(At, 0, 0); PG8_STAGE(PG8_SA(1, 1), a1 + hstepA, voffA);
            PG8_WAIT_V(8); PG8_WAIT_L(0); PG8_BAR; PG8_MMA(0, 0, At, B0); PG8_MMA(0, 1, At, B1); PG8_BAR; PG8_SCHED;
            PG8_LDA(At, 0, 1); PG8_STAGE(PG8_SB(0, 0), b2, voffB); PG8_STAGE(PG8_SB(0, 1), b2 + hstepB, voffB); PG8_STAGE(PG8_SA(0, 0), a2, voffA);
            PG8_WAIT_V(8); PG8_WAIT_L(0); PG8_BAR; PG8_MMA(1, 0, At, B0); PG8_MMA(1, 1, At, B1); PG8_BAR; PG8_SCHED;
            PG8_LDB(B0, 1, 0); PG8_LDB(B1, 1, 1); PG8_SCHED; PG8_LDA(At, 1, 0); PG8_STAGE(PG8_SA(0, 1), a2 + hstepA, voffA);
            PG8_WAIT_V(8); PG8_WAIT_L(0); PG8_BAR; PG8_MMA(0, 0, At, B0); PG8_MMA(0, 1, At, B1); PG8_BAR; PG8_SCHED;
            PG8_LDA(At, 1, 1); PG8_STAGE(PG8_SB(1, 0), b3, voffB); PG8_STAGE(PG8_SB(1, 1), b3 + hstepB, voffB); PG8_STAGE(PG8_SA(1, 0), a3, voffA);
            PG8_WAIT_V(8); PG8_WAIT_L(0); PG8_BAR; PG8_MMA(1, 0, At, B0); PG8_MMA(1, 1, At, B1); PG8_BAR; PG8_SCHED;
        }
        if (wr == 0) PG8_BAR;
        E(acc, cur, wr, wc, fr, fq);
        if (!has_next) break;
#pragma unroll
        for (int a = 0; a < 2; ++a)
#pragma unroll
            for (int b = 0; b < 2; ++b)
#pragma unroll
                for (int m = 0; m < 4; ++m)
#pragma unroll
                    for (int n = 0; n < 2; ++n) acc[a][b][m][n] = (f32x4){0.f, 0.f, 0.f, 0.f};
        cur = nxt; cA = nA; cB = nB; ++ui;
        if (wr == 1) PG8_BAR;
    }
    PG8_WAIT_V(0);
    PG8_BAR;
#undef PG8_SA
#undef PG8_SB
#undef PG8_STAGE
#undef PG8_LDA
#undef PG8_LDB
#undef PG8_MMA
#undef PG8_WAIT_V
#undef PG8_WAIT_L
#undef PG8_BAR
#undef PG8_SCHED
}
}
using pg8::Unit;

struct EpiStore {
    static constexpr bool PERM = true;
    bf16_t* O; long ldc; float scale; const float* ny;
    __device__ __forceinline__ void operator()(const f32x4 (&acc)[2][2][4][2], const Unit& u, int wr, int wc, int fr, int fq) const {
        const int row0 = u.pm * 256 + wr * 64 + fr, col0 = u.pn * 256 + wc * 32 + 8 * fq;
        f32x4 nv[2][2];
#pragma unroll
        for (int bj = 0; bj < 2; ++bj)
#pragma unroll
            for (int n = 0; n < 2; ++n) { nv[bj][n] = ny ? *(const f32x4*)(ny + col0 + bj * 128 + 4 * n) : (f32x4){0.f, 0.f, 0.f, 0.f}; if (fr & 1) nv[bj][n] = -nv[bj][n]; }
#pragma unroll
        for (int ai = 0; ai < 2; ++ai)
#pragma unroll
            for (int m = 0; m < 4; ++m) { bf16_t* rowp = O + (size_t)(row0 + ai * 128 + m * 16) * ldc + col0;
#pragma unroll
                for (int bj = 0; bj < 2; ++bj) { const f32x4 v0 = (acc[ai][bj][m][0] + nv[bj][0]) * scale, v1 = (acc[ai][bj][m][1] + nv[bj][1]) * scale;
                    u32x4 w; w.x = pk2(v0[0], v0[1]); w.y = pk2(v0[2], v0[3]); w.z = pk2(v1[0], v1[1]); w.w = pk2(v1[2], v1[3]);
                    *(u32x4*)(rowp + bj * 128) = w; } }
    }
};
struct EpiSwiglu {
    static constexpr bool PERM = true;
    bf16_t* O;
    __device__ __forceinline__ void operator()(const f32x4 (&acc)[2][2][4][2], const Unit& u, int wr, int wc, int fr, int fq) const {
        const int row0 = u.pm * 256 + wr * 64 + fr, col0 = u.pn * 128 + wc * 32 + 8 * fq;
#pragma unroll
        for (int ai = 0; ai < 2; ++ai)
#pragma unroll
            for (int m = 0; m < 4; ++m) { bf16_t* rowp = O + (size_t)(row0 + ai * 128 + m * 16) * FF + col0;
                float r[8];
#pragma unroll
                for (int n = 0; n < 2; ++n)
#pragma unroll
                    for (int e = 0; e < 4; ++e) { const float gv = acc[ai][0][m][n][e], uv = acc[ai][1][m][n][e];
                        const float sg = gv * __builtin_amdgcn_rcpf(1.0f + __builtin_amdgcn_exp2f(-gv * LOG2E)); r[n * 4 + e] = sg * uv; }
                u32x4 w; w.x = pk2(r[0], r[1]); w.y = pk2(r[2], r[3]); w.z = pk2(r[4], r[5]); w.w = pk2(r[6], r[7]);
                *(u32x4*)rowp = w; }
    }
};
struct EpiQK {
    static constexpr bool PERM = true;
    bf16_t* Q; bf16_t* Kb; const float* qg; const float* kg;
    __device__ __forceinline__ void operator()(const f32x4 (&acc)[2][2][4][2], const Unit& u, int wr, int wc, int fr, int fq) const {
        const bool isq = u.pn < 2; bf16_t* base = isq ? Q : Kb; const float* gp = isq ? qg : kg; const float mul = isq ? QSCALE : 1.0f;
        const int row0 = u.pm * 256 + wr * 64 + fr, col0 = (u.pn & 1) * 256 + wc * 64 + 8 * fq;
        f32x4 gv[2][2];
#pragma unroll
        for (int bj = 0; bj < 2; ++bj)
#pragma unroll
            for (int n = 0; n < 2; ++n) gv[bj][n] = *(const f32x4*)(gp + bj * 32 + 8 * fq + 4 * n) * mul;
#pragma unroll
        for (int ai = 0; ai < 2; ++ai)
#pragma unroll
            for (int m = 0; m < 4; ++m) {
                float ss = 0.f;
#pragma unroll
                for (int bj = 0; bj < 2; ++bj)
#pragma unroll
                    for (int n = 0; n < 2; ++n) { const f32x4 x = acc[ai][bj][m][n]; ss += (x[0] * x[0] + x[1] * x[1]) + (x[2] * x[2] + x[3] * x[3]); }
                { const int ln_ = fq * 16 + fr; ss += shx(ss, 16, ln_); ss += shx(ss, 32, ln_); }
                const float rstd = __builtin_amdgcn_rsqf(ss * (1.0f / 64.0f) + EPS);
                bf16_t* rowp = base + (size_t)(row0 + ai * 128 + m * 16) * 512 + col0;
#pragma unroll
                for (int bj = 0; bj < 2; ++bj) { const f32x4 v0 = acc[ai][bj][m][0] * rstd * gv[bj][0], v1 = acc[ai][bj][m][1] * rstd * gv[bj][1];
                    u32x4 w; w.x = pk2(v0[0], v0[1]); w.y = pk2(v0[2], v0[3]); w.z = pk2(v1[0], v1[1]); w.w = pk2(v1[2], v1[3]);
                    *(u32x4*)(rowp + bj * 32) = w; } }
    }
};
__device__ __forceinline__ int kidx_of(int s, int part) { return ((s >> 6) << 7) + (part << 6) + (s & 63); }
struct EpiVF {
    static constexpr bool PERM = true;
    bf16_t* VT;
    __device__ __forceinline__ void operator()(const f32x4 (&acc)[2][2][4][2], const Unit& u, int wr, int wc, int fr, int fq) const {
        bf16_t* base = VT + (size_t)(u.pm * 256) * T + u.pn * 256;
        const int row0 = wr * 64 + fr;
#pragma unroll
        for (int ai = 0; ai < 2; ++ai)
#pragma unroll
            for (int m = 0; m < 4; ++m) { bf16_t* rowp = base + (size_t)(row0 + ai * 128 + m * 16) * T;
#pragma unroll
                for (int bj = 0; bj < 2; ++bj) { const f32x4 v0 = acc[ai][bj][m][0], v1 = acc[ai][bj][m][1];
                    u32x4 w; w.x = pk2(v0[0], v0[1]); w.y = pk2(v0[2], v0[3]); w.z = pk2(v1[0], v1[1]); w.w = pk2(v1[2], v1[3]);
                    *(u32x4*)(rowp + bj * 128 + wc * 32 + 8 * fq) = w; } }
    }
};
struct EpiF {
    static constexpr bool PERM = true;
    bf16_t* FTP; bf16_t* FTS;
    __device__ __forceinline__ void operator()(const f32x4 (&acc)[2][2][4][2], const Unit& u, int wr, int wc, int fr, int fq) const {
        const int part = u.pm >> 1, tok0 = (u.pn & 63) * 256;
        bf16_t* base; long ldc; int s0;
        if (tok0 < TP / 2) { const int b = tok0 >> 10; s0 = tok0 & 1023; ldc = SEQ_P; base = FTP + (size_t)b * 512 * ldc; }
        else { const int t2 = tok0 - TP / 2; const int b = t2 >> 11; s0 = t2 & 2047; ldc = SEQ_S; base = FTS + (size_t)b * 512 * ldc; }
        base += (size_t)((u.pm & 1) * 256) * ldc;
        const int row0 = wr * 64 + fr;
#pragma unroll
        for (int ai = 0; ai < 2; ++ai)
#pragma unroll
            for (int m = 0; m < 4; ++m) { bf16_t* rowp = base + (size_t)(row0 + ai * 128 + m * 16) * ldc;
#pragma unroll
                for (int bj = 0; bj < 2; ++bj) { const f32x4 v0 = acc[ai][bj][m][0], v1 = acc[ai][bj][m][1];
                    u32x4 w; w.x = pk2(v0[0], v0[1]); w.y = pk2(v0[2], v0[3]); w.z = pk2(v1[0], v1[1]); w.w = pk2(v1[2], v1[3]);
                    *(u32x4*)(rowp + kidx_of(s0 + bj * 128 + wc * 32 + 8 * fq, part)) = w; } }
    }
};
struct EpiResid {
    static constexpr bool PERM = false;
    const float* bp; const float* bs; float* out; const float* gate; float gs;
    __device__ __forceinline__ void operator()(const f32x4 (&acc)[2][2][4][2], const Unit& u, int wr, int wc, int fr, int fq) const {
        const int r0 = u.pm * 256;
        const float* base = r0 < TP ? bp + (size_t)r0 * D : bs + (size_t)(r0 - TP) * D;
        const int b = r0 < TP ? r0 / SEQ_P : 8 + (r0 - TP) / SEQ_S;
        const float* gp = gate + (size_t)b * 9216;
        float* op = out + (size_t)r0 * D;
        const int col0 = u.pn * 256 + wc * 32 + 4 * fq;
        f32x4 gv[2][2];
#pragma unroll
        for (int bj = 0; bj < 2; ++bj)
#pragma unroll
            for (int n = 0; n < 2; ++n) gv[bj][n] = *(const f32x4*)(gp + col0 + bj * 128 + n * 16);
        asm volatile("" ::: "memory");
#pragma unroll
        for (int bj = 0; bj < 2; ++bj)
#pragma unroll
            for (int n = 0; n < 2; ++n) gv[bj][n] = gv[bj][n] * gs;
#pragma unroll
        for (int ai = 0; ai < 2; ++ai)
#pragma unroll
            for (int mp = 0; mp < 2; ++mp) {
                f32x4 pre[2][2][2];
#pragma unroll
                for (int mm = 0; mm < 2; ++mm) { const size_t off = (size_t)(ai * 128 + wr * 64 + (mp * 2 + mm) * 16 + fr) * D + col0;
#pragma unroll
                    for (int bj = 0; bj < 2; ++bj)
#pragma unroll
                        for (int n = 0; n < 2; ++n) pre[mm][bj][n] = *(const f32x4*)(base + off + bj * 128 + n * 16); }
                asm volatile("" ::: "memory");
#pragma unroll
                for (int mm = 0; mm < 2; ++mm) { const size_t off = (size_t)(ai * 128 + wr * 64 + (mp * 2 + mm) * 16 + fr) * D + col0;
#pragma unroll
                    for (int bj = 0; bj < 2; ++bj)
#pragma unroll
                        for (int n = 0; n < 2; ++n) *(f32x4*)(op + off + bj * 128 + n * 16) = pre[mm][bj][n] + gv[bj][n] * acc[ai][bj][mp * 2 + mm][n]; }
                asm volatile("" ::: "memory");
            }
    }
};

typedef _Float16 h16x2_t __attribute__((ext_vector_type(2)));
__device__ __forceinline__ unsigned pkh(float lo, float hi) { f32x2 v; v.x = lo; v.y = hi; h16x2_t h = __builtin_convertvector(v, h16x2_t); return __builtin_bit_cast(unsigned, h); }
__device__ __forceinline__ f32x4 h2f4(unsigned a, unsigned b) { const f32x2 lo = __builtin_convertvector(__builtin_bit_cast(h16x2_t, a), f32x2), hi = __builtin_convertvector(__builtin_bit_cast(h16x2_t, b), f32x2); f32x4 r; r.x = lo.x; r.y = lo.y; r.z = hi.x; r.w = hi.y; return r; }
__device__ __forceinline__ f32x4 bf2lo(unsigned a, unsigned b) { f32x4 r; r.x = __uint_as_float(a << 16); r.y = __uint_as_float(a & 0xffff0000u); r.z = __uint_as_float(b << 16); r.w = __uint_as_float(b & 0xffff0000u); return r; }
template <int MODE> struct EpiResidB {
    static constexpr bool PERM = true;
    const float* bp; const float* bs; bf16_t* XB; float* o_lo; float* o_hi; const float* gate; float gs; const bf16_t* xc_lo; const bf16_t* xc_hi;
    __device__ __forceinline__ void operator()(const f32x4 (&acc)[2][2][4][2], const Unit& u, int wr, int wc, int fr_, int fq_) const {
        const int fr = opaque(fr_), fq = opaque(fq_);
        const int r0 = u.pm * 256;
        const int b = r0 < TP ? r0 / SEQ_P : 8 + (r0 - TP) / SEQ_S;
        const float* gp = gate + (size_t)b * 9216;
        const int col0 = u.pn * 256 + wc * 32 + 8 * fq;
        const float* fb = MODE == 0 ? (r0 < TP ? bp + (size_t)r0 * D : bs + (size_t)(r0 - TP) * D) : nullptr;
        bf16_t* xb = MODE == 2 ? (bf16_t*)(r0 < TP ? xc_lo + (size_t)r0 * D : xc_hi + (size_t)(r0 - TP) * D) : XB + (size_t)r0 * D;
        float* fo = MODE == 2 ? (r0 < TP ? o_lo + (size_t)r0 * D : o_hi + (size_t)(r0 - TP) * D) : nullptr;
        f32x4 gv[2][2];
#pragma unroll
        for (int bj = 0; bj < 2; ++bj)
#pragma unroll
            for (int n = 0; n < 2; ++n) gv[bj][n] = *(const f32x4*)(gp + col0 + bj * 128 + 4 * n);
        asm volatile("" ::: "memory");
#pragma unroll
        for (int bj = 0; bj < 2; ++bj)
#pragma unroll
            for (int n = 0; n < 2; ++n) gv[bj][n] = gv[bj][n] * gs;
#pragma unroll
        for (int ai = 0; ai < 2; ++ai) {
            if (MODE == 0) {
#pragma unroll
                for (int mp = 0; mp < 2; ++mp) {
                    f32x4 pre[2][2][2];
#pragma unroll
                    for (int mm = 0; mm < 2; ++mm) { const size_t off = (size_t)(ai * 128 + wr * 64 + (mp * 2 + mm) * 16 + fr) * D + col0;
#pragma unroll
                        for (int bj = 0; bj < 2; ++bj) { pre[mm][bj][0] = *(const f32x4*)(fb + off + bj * 128); pre[mm][bj][1] = *(const f32x4*)(fb + off + bj * 128 + 4); } }
                    asm volatile("" ::: "memory");
#pragma unroll
                    for (int mm = 0; mm < 2; ++mm) { const size_t off = (size_t)(ai * 128 + wr * 64 + (mp * 2 + mm) * 16 + fr) * D + col0;
#pragma unroll
                        for (int bj = 0; bj < 2; ++bj) { const f32x4 v0 = pre[mm][bj][0] + gv[bj][0] * acc[ai][bj][mp * 2 + mm][0], v1 = pre[mm][bj][1] + gv[bj][1] * acc[ai][bj][mp * 2 + mm][1];
                            u32x4 w; w.x = pkh(v0[0], v0[1]); w.y = pkh(v0[2], v0[3]); w.z = pkh(v1[0], v1[1]); w.w = pkh(v1[2], v1[3]); *(u32x4*)(xb + off + bj * 128) = w; } }
                    asm volatile("" ::: "memory");
                }
            } else {
                u32x4 raw[4][2];
#pragma unroll
                for (int m = 0; m < 4; ++m) { const size_t off = (size_t)(ai * 128 + wr * 64 + m * 16 + fr) * D + col0;
#pragma unroll
                    for (int bj = 0; bj < 2; ++bj) raw[m][bj] = *(const u32x4*)(xb + off + bj * 128); }
                asm volatile("" ::: "memory");
#pragma unroll
                for (int m = 0; m < 4; ++m) { const size_t off = (size_t)(ai * 128 + wr * 64 + m * 16 + fr) * D + col0;
#pragma unroll
                    for (int bj = 0; bj < 2; ++bj) { const f32x4 v0 = h2f4(raw[m][bj].x, raw[m][bj].y) + gv[bj][0] * acc[ai][bj][m][0], v1 = h2f4(raw[m][bj].z, raw[m][bj].w) + gv[bj][1] * acc[ai][bj][m][1];
                        if (MODE == 2) { *(f32x4*)(fo + off + bj * 128) = v0; *(f32x4*)(fo + off + bj * 128 + 4) = v1; }
                        else { u32x4 w; w.x = pkh(v0[0], v0[1]); w.y = pkh(v0[2], v0[3]); w.z = pkh(v1[0], v1[1]); w.w = pkh(v1[2], v1[3]); *(u32x4*)(xb + off + bj * 128) = w; } } }
                asm volatile("" ::: "memory");
            }
        }
    }
};

struct Args { const float* in[20]; float* out; unsigned char* ws; int ph_lo, ph_hi; };
enum { I_XP = 0, I_XS, I_CP, I_CS, I_ADAW, I_ADAB, I_NF1, I_NMIX, I_NF2, I_F1WI, I_F1WO, I_F2WI, I_F2WO, I_WIN, I_WOUT, I_QN, I_KN, I_LQK, I_SUBLN, I_RELB };

constexpr int LDS_BYTES = 147456;
constexpr int AK_OFF = 0, AK_STRIDE = 272, AK_BUF = 64 * 272, AV_OFF = AK_OFF + 2 * AK_BUF, AV_STRIDE = 144, AV_BUF = 128 * 144;
constexpr int ATAB_OFF = AV_OFF + 2 * AV_BUF;
constexpr int AQ_OFF = ATAB_OFF + 2304, AQ_STRIDE = 272, ASUB_OFF = AQ_OFF + 128 * 272;
constexpr int QUEUE_OFF = LDS_BYTES - 16, BARST_OFF = LDS_BYTES - 32;
static_assert(ASUB_OFF + 512 <= BARST_OFF && ATAB_OFF >= 65536, "lds map");

__device__ __forceinline__ void transpose_item(const float* W, int ldw, int scol0, int k0, bf16_t* WT, int K, int drow0, LAS float* scr, int lane) {
    float tv[32];
#pragma unroll
    for (int i = 0; i < 32; ++i) { const int kk = 2 * i + (lane >> 5); tv[i] = __builtin_nontemporal_load(W + (size_t)(k0 + kk) * ldw + scol0 + (lane & 31)); }
#pragma unroll
    for (int i = 0; i < 32; ++i) { const int kk = 2 * i + (lane >> 5); scr[kk * 33 + (lane & 31)] = tv[i]; }
    LDS_WAIT(); asm volatile("" ::: "memory");
    const int c = lane & 7;
#pragma unroll
    for (int j = 0; j < 4; ++j) { const int n = (lane >> 3) + 8 * j; const LAS float* s = scr + (8 * c) * 33 + n;
        u32x4 o; o.x = pk2(s[0 * 33], s[1 * 33]); o.y = pk2(s[2 * 33], s[3 * 33]); o.z = pk2(s[4 * 33], s[5 * 33]); o.w = pk2(s[6 * 33], s[7 * 33]);
        *(u32x4*)(WT + (size_t)(drow0 + n) * K + k0 + 8 * c) = o; }
    LDS_WAIT(); asm volatile("" ::: "memory");
}

__device__ __forceinline__ void convert_weights(const Args& a, int l, LAS unsigned char* lds, int gw, int ngw, int wave) {
    const int lane = opaque((int)threadIdx.x) & 63;
    LAS float* scr = (LAS float*)(lds + wave * 17408);
    unsigned char* ws = a.ws;
    constexpr int I_WI = 16 * 176, I_WO = 44 * 32, I_QK = 16 * 32, I_V = 16 * 16, I_OUT = 16 * 32, I_F = 8 * 16 * 8;
    constexpr int NITEMS = I_F + 2 * I_WI + 2 * I_WO + I_QK + I_V + I_OUT;
    const float* win = a.in[I_WIN] + (size_t)l * 1024 * 2048;
    for (int it = gw; it < NITEMS; it += ngw) {
        int r = it;
        if (r < I_F) {
            const int cpo = r & 7, kb = (r >> 3) & 15, g = r >> 7, k0 = kb * 64;
            LAS float* ct = scr + 64 * 65;
            ct[lane] = cospif((float)lane * (1.0f / 32.0f));
#pragma unroll
            for (int hb = 0; hb < 2; ++hb) { float fv[32];
#pragma unroll
                for (int i = 0; i < 32; ++i) fv[i] = __builtin_nontemporal_load(win + (size_t)(k0 + hb * 32 + i) * 2048 + 1536 + g * 64 + lane);
#pragma unroll
                for (int i = 0; i < 32; ++i) scr[(hb * 32 + i) * 65 + lane] = fv[i]; }
            LDS_WAIT(); asm volatile("" ::: "memory");
            bf16_t* WF = (bf16_t*)(ws + WS_WVF) + (size_t)512 * 1024;
            float ac[8], as[8];
#pragma unroll
            for (int q = 0; q < 8; ++q) { ac[q] = 0.f; as[q] = 0.f; }
            for (int c = 0; c < 64; ++c) { const float w = scr[lane * 65 + c];
#pragma unroll
                for (int q = 0; q < 8; ++q) { const int m = (c * (cpo * 8 + q)) & 63; ac[q] += w * ct[m]; as[q] += w * ct[(m + 48) & 63]; } }
#pragma unroll
            for (int q = 0; q < 8; ++q) { const int cp = cpo * 8 + q;
                WF[(size_t)(g * 64 + cp) * 1024 + k0 + lane] = (unsigned short)(pk2(ac[q], 0.f) & 0xffffu);
                WF[(size_t)(512 + g * 64 + cp) * 1024 + k0 + lane] = (unsigned short)(pk2(as[q], 0.f) & 0xffffu); }
            LDS_WAIT(); asm volatile("" ::: "memory");
            continue; }
        r -= I_F;
        if (r < 2 * I_WI) { const int which = r / I_WI; r -= which * I_WI; const int kb = r / 176, rb = r % 176, p0 = 32 * rb, pn = p0 >> 8, bj = (p0 >> 7) & 1, c0 = p0 & 127;
            const float* W = (which ? a.in[I_F2WI] : a.in[I_F1WI]) + (size_t)l * 1024 * 5632;
            transpose_item(W, 5632, bj * 2816 + pn * 128 + c0, kb * 64, (bf16_t*)(ws + (which ? WS_WI2 : WS_WI1)), 1024, p0, scr, lane); continue; }
        r -= 2 * I_WI;
        if (r < 2 * I_WO) { const int which = r / I_WO; r -= which * I_WO; const int kb = r / 32, rb = r % 32;
            const float* W = (which ? a.in[I_F2WO] : a.in[I_F1WO]) + (size_t)l * 2816 * 1024;
            transpose_item(W, 1024, 32 * rb, kb * 64, (bf16_t*)(ws + (which ? WS_WO2 : WS_WO1)), 2816, 32 * rb, scr, lane); continue; }
        r -= 2 * I_WO;
        if (r < I_QK) { const int kb = r / 32, rb = r % 32, p0 = 32 * rb, pn = p0 >> 8, pp = p0 & 255, bj = pp >> 7, wc = (pp & 127) >> 5;
            transpose_item(win, 2048, pn * 256 + wc * 64 + bj * 32, kb * 64, (bf16_t*)(ws + WS_WQK), 1024, p0, scr, lane); continue; }
        r -= I_QK;
        if (r < I_V) { const int kb = r / 16, rb = r % 16;
            transpose_item(win, 2048, 1024 + 32 * rb, kb * 64, (bf16_t*)(ws + WS_WVF), 1024, 32 * rb, scr, lane); continue; }
        r -= I_V;
        { const int kb = r / 32, rb = r % 32;
            transpose_item(a.in[I_WOUT] + (size_t)l * 1024 * 1024, 1024, 32 * rb, kb * 64, (bf16_t*)(ws + WS_WOUT), 1024, 32 * rb, scr, lane); }
    }
}

__device__ __forceinline__ int rel_bucket(int rel) {
    int ret = rel > 0 ? 16 : 0; const int n = rel < 0 ? -rel : rel;
    if (n < 8) return ret + n;
    const float nf = (float)n;
    int large = 8 + (int)(logf(nf / 8.0f) / 2.772588722239781f * 8.0f);
    large = large < 15 ? large : 15;
    return ret + large;
}

template <bool SRC_BF16>
__device__ __forceinline__ void norm_row_one(int m, int lane, const float* xp, const float* xs, const bf16_t* XB, const float* g, const float* mod, int chunk_shift, bf16_t* XN, bf16_t* xc_lo, bf16_t* xc_hi) {
    const int b = m < TP ? m / SEQ_P : 8 + (m - TP) / SEQ_S;
    const float* sh = mod + (size_t)b * 9216 + chunk_shift * 1024; const float* sc = sh + 1024;
    f32x4 v[4]; float s = 0.f;
    if (SRC_BF16) { const u32x2* xr = (const u32x2*)(XB + (size_t)m * D) + lane;
#pragma unroll
        for (int j = 0; j < 4; ++j) { const u32x2 w = xr[64 * j]; v[j] = h2f4(w.x, w.y);
            if (xc_lo) { u32x2* xc = (u32x2*)(m < TP ? xc_lo + (size_t)m * D : xc_hi + (size_t)(m - TP) * D) + lane; xc[64 * j] = w; } }
    } else { const float* xrow = m < TP ? xp + (size_t)m * D : xs + (size_t)(m - TP) * D; const f32x4* xr = (const f32x4*)xrow + lane;
#pragma unroll
        for (int j = 0; j < 4; ++j) v[j] = xr[64 * j]; }
#pragma unroll
    for (int j = 0; j < 4; ++j) s += (v[j].x * v[j].x + v[j].y * v[j].y) + (v[j].z * v[j].z + v[j].w * v[j].w);
    const float rstd = 1.0f / sqrtf(wave_sum(s, lane) * (1.0f / D) + EPS);
    unsigned long long* o8 = (unsigned long long*)(XN + (size_t)m * D) + lane;
#pragma unroll
    for (int j = 0; j < 4; ++j) { const f32x4 gg = ((const f32x4*)g)[64 * j + lane], s1 = ((const f32x4*)sc)[64 * j + lane], s0 = ((const f32x4*)sh)[64 * j + lane];
        const f32x4 y = v[j] * rstd * gg * (s1 + 1.0f) + s0;
        o8[64 * j] = (unsigned long long)pk2(y.x, y.y) | ((unsigned long long)pk2(y.z, y.w) << 32); }
}
template <bool SRC_BF16>
__device__ __forceinline__ void norm_rows(const float* xp, const float* xs, const bf16_t* XB, const float* g, const float* mod  , int chunk_shift, bf16_t* XN, int gw, int ngw, bf16_t* xc_lo = nullptr, bf16_t* xc_hi = nullptr) {
    const int lane = opaque((int)threadIdx.x) & 63;
    const int rpw = T / ngw;
    if (T % ngw != 0 || (rpw & 3) != 0 || SEQ_P % rpw != 0) { for (int m = gw; m < T; m += ngw) norm_row_one<SRC_BF16>(m, lane, xp, xs, XB, g, mod, chunk_shift, XN, xc_lo, xc_hi); return; }
    const int mb = gw * rpw, b = mb < TP ? mb / SEQ_P : 8 + (mb - TP) / SEQ_S;
    const float* sh = mod + (size_t)b * 9216 + chunk_shift * 1024; const float* sc = sh + 1024;
    f32x4 mm[4], s0[4];
#pragma unroll
    for (int j = 0; j < 4; ++j) { const f32x4 gg = ((const f32x4*)g)[64 * j + lane], s1 = ((const f32x4*)sc)[64 * j + lane]; s0[j] = ((const f32x4*)sh)[64 * j + lane]; mm[j] = gg * (s1 + 1.0f); }
    for (int i = 0; i < rpw; i += 4) {
        f32x4 v[4][4];
#pragma unroll
        for (int q = 0; q < 4; ++q) { const int m = mb + i + q;
            if (SRC_BF16) { const u32x2* xr = (const u32x2*)(XB + (size_t)m * D) + lane;
#pragma unroll
                for (int j = 0; j < 4; ++j) { const u32x2 w = xr[64 * j]; v[q][j] = h2f4(w.x, w.y);
                    if (xc_lo) { u32x2* xc = (u32x2*)(m < TP ? xc_lo + (size_t)m * D : xc_hi + (size_t)(m - TP) * D) + lane; xc[64 * j] = w; } }
            } else { const float* xrow = m < TP ? xp + (size_t)m * D : xs + (size_t)(m - TP) * D; const f32x4* xr = (const f32x4*)xrow + lane;
#pragma unroll
                for (int j = 0; j < 4; ++j) v[q][j] = xr[64 * j]; } }
#pragma unroll
        for (int q = 0; q < 4; ++q) { const int m = mb + i + q; float s = 0.f;
#pragma unroll
            for (int j = 0; j < 4; ++j) s += (v[q][j].x * v[q][j].x + v[q][j].y * v[q][j].y) + (v[q][j].z * v[q][j].z + v[q][j].w * v[q][j].w);
            const float rstd = 1.0f / sqrtf(wave_sum(s, lane) * (1.0f / D) + EPS);
            unsigned long long* o8 = (unsigned long long*)(XN + (size_t)m * D) + lane;
#pragma unroll
            for (int j = 0; j < 4; ++j) { const f32x4 y = v[q][j] * rstd * mm[j] + s0[j];
                o8[64 * j] = (unsigned long long)pk2(y.x, y.y) | ((unsigned long long)pk2(y.z, y.w) << 32); } }
    }
}

__device__ __forceinline__ void pair_rows(int it, int& b, int& s, int& r1, int& r2) {
    int S, tokb;
    if (it < TP / 2) { b = it >> 10; s = it & 1023; S = SEQ_P; tokb = b * SEQ_P; }
    else { const int i2 = it - TP / 2; b = 8 + (i2 >> 11); s = i2 & 2047; S = SEQ_S; tokb = TP + (b - 8) * SEQ_S; }
    r1 = tokb + s; r2 = tokb + (s == 0 ? S / 2 : S - s);
}
__device__ __forceinline__ void norm_rows_paired(const bf16_t* x, const float* g, const float* mod, int chunk_shift, bf16_t* XN, bf16_t* XFc, bf16_t* XFs, int gw, int ngw) {
    const int lane = opaque((int)threadIdx.x) & 63;
    const int ppw = (T / 2) / ngw;
    const bool block = ((T / 2) % ngw == 0) && ((ppw & 1) == 0) && (1024 % ppw == 0);
    const int it_lo = block ? gw * ppw : gw, it_step = block ? 2 : 2 * ngw, it_hi = block ? gw * ppw + ppw : T / 2, it_d = block ? 1 : ngw;
    int b0, sdummy, rd1, rd2; pair_rows(it_lo < T / 2 ? it_lo : 0, b0, sdummy, rd1, rd2);
    f32x4 mm[4], s0[4];
    if (block) { const float* sh = mod + (size_t)b0 * 9216 + chunk_shift * 1024; const float* sc = sh + 1024;
#pragma unroll
        for (int j = 0; j < 4; ++j) { const f32x4 gg = ((const f32x4*)g)[64 * j + lane], s1 = ((const f32x4*)sc)[64 * j + lane]; s0[j] = ((const f32x4*)sh)[64 * j + lane]; mm[j] = gg * (s1 + 1.0f); } }
    for (int it0 = it_lo; it0 < it_hi; it0 += it_step) {
        f32x4 v[2][2][4]; int sv[2], r1v[2], r2v[2], itv[2], bv[2];
#pragma unroll
        for (int q = 0; q < 2; ++q) { const int it = (it0 + q * it_d < T / 2) ? it0 + q * it_d : it0; itv[q] = it; pair_rows(it, bv[q], sv[q], r1v[q], r2v[q]);
            const u32x2* x1 = (const u32x2*)(x + (size_t)r1v[q] * D) + lane; const u32x2* x2 = (const u32x2*)(x + (size_t)r2v[q] * D) + lane;
#pragma unroll
            for (int j = 0; j < 4; ++j) { const u32x2 w1 = x1[64 * j], w2 = x2[64 * j]; v[q][0][j] = h2f4(w1.x, w1.y); v[q][1][j] = h2f4(w2.x, w2.y); } }
#pragma unroll
        for (int q = 0; q < 2; ++q) {
            if (!block) { const float* sh = mod + (size_t)bv[q] * 9216 + chunk_shift * 1024; const float* sc = sh + 1024;
#pragma unroll
                for (int j = 0; j < 4; ++j) { const f32x4 gg = ((const f32x4*)g)[64 * j + lane], s1 = ((const f32x4*)sc)[64 * j + lane]; s0[j] = ((const f32x4*)sh)[64 * j + lane]; mm[j] = gg * (s1 + 1.0f); } }
            float q1 = 0.f, q2 = 0.f;
#pragma unroll
            for (int j = 0; j < 4; ++j) { const f32x4 a1 = v[q][0][j], a2 = v[q][1][j];
                q1 += (a1.x * a1.x + a1.y * a1.y) + (a1.z * a1.z + a1.w * a1.w); q2 += (a2.x * a2.x + a2.y * a2.y) + (a2.z * a2.z + a2.w * a2.w); }
            const float rs1 = 1.0f / sqrtf(wave_sum(q1, lane) * (1.0f / D) + EPS), rs2 = 1.0f / sqrtf(wave_sum(q2, lane) * (1.0f / D) + EPS);
            const int s = sv[q], it = itv[q];
            unsigned long long* o1 = (unsigned long long*)(XN + (size_t)r1v[q] * D) + lane; unsigned long long* o2 = (unsigned long long*)(XN + (size_t)r2v[q] * D) + lane;
            unsigned long long* oc = (unsigned long long*)(XFc + (size_t)it * D) + lane; unsigned long long* os = (unsigned long long*)(XFs + (size_t)it * D) + lane;
#pragma unroll
            for (int j = 0; j < 4; ++j) {
                const f32x4 y1 = v[q][0][j] * rs1 * mm[j] + s0[j], y2 = v[q][1][j] * rs2 * mm[j] + s0[j];
                const f32x4 yc = s == 0 ? y1 : y1 + y2; const f32x4 ys = s == 0 ? (f32x4){0.f, 0.f, 0.f, 0.f} : y1 - y2;
                o1[64 * j] = (unsigned long long)pk2(y1.x, y1.y) | ((unsigned long long)pk2(y1.z, y1.w) << 32);
                o2[64 * j] = (unsigned long long)pk2(y2.x, y2.y) | ((unsigned long long)pk2(y2.z, y2.w) << 32);
                oc[64 * j] = (unsigned long long)pk2(yc.x, yc.y) | ((unsigned long long)pk2(yc.z, yc.w) << 32);
                os[64 * j] = (unsigned long long)pk2(ys.x, ys.y) | ((unsigned long long)pk2(ys.z, ys.w) << 32); }
        }
    }
}

__device__ __forceinline__ void attn_unit(LAS unsigned char* lds, const bf16_t* Q, const bf16_t* Kb, const bf16_t* VT, bf16_t* MIX, const float* bt  ,
                                          const float* subln, float lam, float one_minus_li, int bg, int h, int qb) {
    const int tid = opaque((int)threadIdx.x), wave = __builtin_amdgcn_readfirstlane(tid >> 6), lane = tid & 63, r = lane & 31, h2 = lane >> 5;
    const int j = wave >> 2, wq = wave & 3;
    const int S = bg < 8 ? SEQ_P : SEQ_S;
    const int tok0 = bg < 8 ? bg * SEQ_P : TP + (bg - 8) * SEQ_S;
    const int nkt = S / 64;
    u32x4 qv[4]; float tb0, tb1 = 0.f, sbv = 0.f;
    {
        const bf16_t* qsrc = Q + (size_t)(tok0 + qb * 128) * 512 + h * 128;
#pragma unroll
        for (int i = 0; i < 4; ++i) { const int c = tid + i * 512, row = c >> 4, cc = c & 15; qv[i] = *(const u32x4*)(qsrc + (size_t)row * 512 + cc * 8); }
        tb0 = bt[h * 520 + tid]; if (tid < 8) tb1 = bt[h * 520 + 512 + tid];
        if (tid < 128) sbv = subln[tid];
    }
    const LAS unsigned char* qbase = lds + AQ_OFF + (wq * 32 + r) * AQ_STRIDE + j * 128 + h2 * 16;
    const bf16_t* ksrc = Kb + (size_t)tok0 * 512 + h * 128;
    const bf16_t* vsrc = VT + (size_t)(h * 128) * T + tok0;
    u32x4 sa[4], sb[4];
    const int krow0 = tid >> 4, kcc = tid & 15, vrow0 = tid >> 3, vcc = tid & 7;
    const int vwoff = 32 * (vcc >> 1) + 8 * (vcc & 1);
#define ATT_LOAD(stg, kt) do { \
        stg[0] = *(const u32x4*)(ksrc + (size_t)((kt) * 64 + krow0) * 512 + kcc * 8); \
        stg[1] = *(const u32x4*)(ksrc + (size_t)((kt) * 64 + krow0 + 32) * 512 + kcc * 8); \
        stg[2] = *(const u32x4*)(vsrc + (size_t)vrow0 * T + (kt) * 64 + vcc * 8); \
        stg[3] = *(const u32x4*)(vsrc + (size_t)(vrow0 + 64) * T + (kt) * 64 + vcc * 8); } while (0)
#define ATT_STORE(stg, buf) do { \
        *(LAS u32x4*)(lds + AK_OFF + (buf) * AK_BUF + krow0 * AK_STRIDE + kcc * 16) = stg[0]; \
        *(LAS u32x4*)(lds + AK_OFF + (buf) * AK_BUF + (krow0 + 32) * AK_STRIDE + kcc * 16) = stg[1]; \
        { LAS unsigned char* p = lds + AV_OFF + (buf) * AV_BUF + vrow0 * AV_STRIDE + vwoff; u32x2 lo, hi; lo.x = stg[2].x; lo.y = stg[2].y; hi.x = stg[2].z; hi.y = stg[2].w; *(LAS u32x2*)p = lo; *(LAS u32x2*)(p + 16) = hi; } \
        { LAS unsigned char* p = lds + AV_OFF + (buf) * AV_BUF + (vrow0 + 64) * AV_STRIDE + vwoff; u32x2 lo, hi; lo.x = stg[3].x; lo.y = stg[3].y; hi.x = stg[3].z; hi.y = stg[3].w; *(LAS u32x2*)p = lo; *(LAS u32x2*)(p + 16) = hi; } } while (0)
    ATT_LOAD(sa, 0);
    ATT_LOAD(sb, 1);
    asm volatile("" ::: "memory");
    {
#pragma unroll
        for (int i = 0; i < 4; ++i) { const int c = tid + i * 512, row = c >> 4, cc = c & 15; *(LAS u32x4*)(lds + AQ_OFF + row * AQ_STRIDE + cc * 16) = qv[i]; }
        LAS float* tabw = (LAS float*)(lds + ATAB_OFF);
        tabw[tid] = tb0; if (tid < 8) tabw[512 + tid] = tb1;
        if (tid < 128) ((LAS float*)(lds + ASUB_OFF))[tid] = sbv;
    }
    ATT_STORE(sa, 0);
    __syncthreads();

    f32x16 O[4];
#pragma unroll
    for (int d = 0; d < 4; ++d)
#pragma unroll
        for (int i = 0; i < 16; ++i) O[d][i] = 0.f;
    float lsum = 0.f;
    const LAS float* tab = (const LAS float*)(lds + ATAB_OFF) + j * 260;
    const int qmin = qb * 128 + wq * 32;

#define ATT_TILE(buf, kt) do { \
        const LAS unsigned char* kbase = lds + AK_OFF + buf * AK_BUF + r * AK_STRIDE + j * 128 + h2 * 16; \
        const LAS unsigned char* vbase = lds + AV_OFF + buf * AV_BUF + r * AV_STRIDE + h2 * 16; \
        const int kmin = kt * 64; \
        const int cls = (kmin - (qmin + 31) >= 128) ? 1 : ((kmin + 63 - qmin <= -128) ? -1 : 0); \
        __builtin_amdgcn_s_setprio(1); \
        bf16x8 KF[8], qf[4]; \
_Pragma("unroll") \
        for (int s = 0; s < 4; ++s) qf[s] = *(const LAS bf16x8*)(qbase + s * 32); \
_Pragma("unroll") \
        for (int kb = 0; kb < 2; ++kb) \
_Pragma("unroll") \
            for (int s = 0; s < 4; ++s) KF[kb * 4 + s] = *(const LAS bf16x8*)(kbase + kb * 32 * AK_STRIDE + s * 32); \
        __builtin_amdgcn_sched_barrier(0); \
        f32x16 st[2]; \
        f32x2 ls2 = (f32x2){0.f, 0.f}; \
        float bcv = 0.f; \
        if (cls != 0) { \
            bcv = cls > 0 ? tab[256] : tab[0]; \
_Pragma("unroll") \
            for (int kb = 0; kb < 2; ++kb) { \
_Pragma("unroll") \
                for (int i = 0; i < 16; ++i) st[kb][i] = 0.f; \
_Pragma("unroll") \
                for (int s = 0; s < 4; ++s) st[kb] = __builtin_amdgcn_mfma_f32_32x32x16_bf16(KF[kb * 4 + s], qf[s], st[kb], 0, 0, 0); \
            } \
        } else { \
            const int relb = kmin - (qmin + r) + 4 * h2 + 128; \
_Pragma("unroll") \
            for (int kb = 0; kb < 2; ++kb) { \
_Pragma("unroll") \
                for (int i = 0; i < 16; ++i) { int idx = relb + kb * 32 + (i & 3) + 8 * (i >> 2); idx = idx < 0 ? 0 : (idx > 256 ? 256 : idx); st[kb][i] = tab[idx]; } \
_Pragma("unroll") \
                for (int s = 0; s < 4; ++s) st[kb] = __builtin_amdgcn_mfma_f32_32x32x16_bf16(KF[kb * 4 + s], qf[s], st[kb], 0, 0, 0); \
            } \
        } \
        __builtin_amdgcn_s_setprio(0); \
        __builtin_amdgcn_sched_barrier(0); \
        bf16x8 V0[4], V1[4]; \
_Pragma("unroll") \
        for (int sp = 0; sp < 4; ++sp) V0[sp] = *(const LAS bf16x8*)(vbase + sp * 32); \
        __builtin_amdgcn_sched_barrier(0); \
_Pragma("unroll") \
        for (int kb = 0; kb < 2; ++kb) \
_Pragma("unroll") \
            for (int i = 0; i < 16; i += 2) { const float p0 = __builtin_amdgcn_exp2f(st[kb][i] + bcv), p1 = __builtin_amdgcn_exp2f(st[kb][i + 1] + bcv); st[kb][i] = p0; st[kb][i + 1] = p1; ls2 += (f32x2){p0, p1}; } \
        lsum += ls2.x + ls2.y; \
        bf16x8 P[4]; \
_Pragma("unroll") \
        for (int sp = 0; sp < 4; ++sp) { const int kb = sp >> 1, o = (sp & 1) * 8; u32x4 w; \
            w.x = pk2(st[kb][o + 0], st[kb][o + 1]); w.y = pk2(st[kb][o + 2], st[kb][o + 3]); w.z = pk2(st[kb][o + 4], st[kb][o + 5]); w.w = pk2(st[kb][o + 6], st[kb][o + 7]); \
            P[sp] = __builtin_bit_cast(bf16x8, w); } \
        __builtin_amdgcn_sched_barrier(0); \
_Pragma("unroll") \
        for (int sp = 0; sp < 4; ++sp) V1[sp] = *(const LAS bf16x8*)(vbase + 1 * 32 * AV_STRIDE + sp * 32); \
        __builtin_amdgcn_sched_barrier(0); \
        __builtin_amdgcn_s_setprio(1); \
_Pragma("unroll") \
        for (int sp = 0; sp < 4; ++sp) O[0] = __builtin_amdgcn_mfma_f32_32x32x16_bf16(V0[sp], P[sp], O[0], 0, 0, 0); \
        __builtin_amdgcn_sched_barrier(0); \
_Pragma("unroll") \
        for (int sp = 0; sp < 4; ++sp) V0[sp] = *(const LAS bf16x8*)(vbase + 2 * 32 * AV_STRIDE + sp * 32); \
        __builtin_amdgcn_sched_barrier(0); \
_Pragma("unroll") \
        for (int sp = 0; sp < 4; ++sp) O[1] = __builtin_amdgcn_mfma_f32_32x32x16_bf16(V1[sp], P[sp], O[1], 0, 0, 0); \
        __builtin_amdgcn_sched_barrier(0); \
_Pragma("unroll") \
        for (int sp = 0; sp < 4; ++sp) V1[sp] = *(const LAS bf16x8*)(vbase + 3 * 32 * AV_STRIDE + sp * 32); \
        __builtin_amdgcn_sched_barrier(0); \
_Pragma("unroll") \
        for (int sp = 0; sp < 4; ++sp) O[2] = __builtin_amdgcn_mfma_f32_32x32x16_bf16(V0[sp], P[sp], O[2], 0, 0, 0); \
_Pragma("unroll") \
        for (int sp = 0; sp < 4; ++sp) O[3] = __builtin_amdgcn_mfma_f32_32x32x16_bf16(V1[sp], P[sp], O[3], 0, 0, 0); \
        __builtin_amdgcn_s_setprio(0); \
        __builtin_amdgcn_sched_barrier(0); \
    } while (0)
#define ATT_BAR() do { asm volatile("s_waitcnt lgkmcnt(0)" ::: "memory"); __builtin_amdgcn_s_barrier(); asm volatile("" ::: "memory"); } while (0)
    for (int kt2 = 0; kt2 < nkt; kt2 += 2) {
        if (kt2 + 2 < nkt) ATT_LOAD(sa, kt2 + 2);
        ATT_TILE(0, kt2);
        ATT_STORE(sb, 1);
        ATT_BAR();
        if (kt2 + 3 < nkt) ATT_LOAD(sb, kt2 + 3);
        ATT_TILE(1, (kt2 + 1));
        if (kt2 + 2 < nkt) ATT_STORE(sa, 0);
        ATT_BAR();
    }
#undef ATT_BAR
#undef ATT_TILE
#undef ATT_LOAD
#undef ATT_STORE
    lsum += shx(lsum, 32, lane);
    LAS float* X = (LAS float*)lds + (size_t)wq * 4096 + lane;
    if (j == 1) {
        const float sc = lam / lsum;
#pragma unroll
        for (int d = 0; d < 4; ++d)
#pragma unroll
            for (int i = 0; i < 16; ++i) X[(d * 16 + i) * 64] = O[d][i] * sc;
    }
    __syncthreads();
    if (j == 0) {
        const float i1 = 1.0f / lsum;
        float ss = 0.f;
#pragma unroll
        for (int d = 0; d < 4; ++d)
#pragma unroll
            for (int i = 0; i < 16; ++i) { const float o = O[d][i] * i1 - X[(d * 16 + i) * 64]; O[d][i] = o; ss += o * o; }
        ss += shx(ss, 32, lane);
        const float rs = __builtin_amdgcn_rsqf(ss * (1.0f / 128.0f) + EPS) * one_minus_li;
        LAS unsigned char* stage = (LAS unsigned char*)lds + (size_t)wq * 16384;
        asm volatile("s_waitcnt lgkmcnt(0)" ::: "memory");
#pragma unroll
        for (int d = 0; d < 4; ++d)
#pragma unroll
            for (int g = 0; g < 4; ++g) { const int dd = d * 32 + 8 * g + 4 * h2; const f32x4 sg = *(const LAS f32x4*)(lds + ASUB_OFF + dd * 4);
                u32x2 w; w.x = pk2(O[d][4 * g + 0] * rs * sg.x, O[d][4 * g + 1] * rs * sg.y); w.y = pk2(O[d][4 * g + 2] * rs * sg.z, O[d][4 * g + 3] * rs * sg.w);
                *(LAS u32x2*)(stage + r * 272 + dd * 2) = w; }
        asm volatile("s_waitcnt lgkmcnt(0)" ::: "memory");
        bf16_t* obase = MIX + (size_t)(tok0 + qb * 128 + wq * 32) * D + h * 128;
#pragma unroll
        for (int i = 0; i < 8; ++i) { const int row = (lane >> 4) + 4 * i, ch = lane & 15;
            const u32x4 v = *(const LAS u32x4*)(stage + row * 272 + ch * 16);
            *(u32x4*)(obase + (size_t)row * D + ch * 8) = v; }
    }
}

__global__ void __launch_bounds__(512, 2) mega_fwd(Args a) {
    extern __shared__ __attribute__((aligned(16))) unsigned char lds_raw[];
    LAS unsigned char* lds = (LAS unsigned char*)lds_raw;
    cg::grid_group grid = cg::this_grid();
    const int wave = __builtin_amdgcn_readfirstlane((int)threadIdx.x >> 6);
    const int G = gridDim.x, bx = blockIdx.x;
    const int gw = bx * 8 + wave, ngw = G * 8;
#define WSP ({ unsigned long long p_ = (unsigned long long)a.ws; asm volatile("" : "+s"(p_)); (unsigned char*)p_; })
#define ctl ((unsigned*)(WSP + WS_CTL))
#define miscf ((float*)(WSP + WS_MISC))
#define BT ((float*)(WSP + WS_BT))
#define MOD ((float*)(WSP + WS_MOD))
#define XN ((bf16_t*)(WSP + WS_XN))
#define MIX XN
#define ACT ((bf16_t*)(WSP + WS_BIG))
#define Qb ((bf16_t*)(WSP + WS_Q))
#define Kb ((bf16_t*)(WSP + WS_K))
#define VT ((bf16_t*)(WSP + WS_VT))
#define FTS ((bf16_t*)(WSP + WS_FTS))
#define FTP ((bf16_t*)(WSP + WS_FTP))
#define XFc ((bf16_t*)(WSP + WS_XFC))
#define XFs ((bf16_t*)(WSP + WS_XFS))
#define NY ((float*)(WSP + WS_NY))
#define DFT ((bf16_t*)(WSP + WS_DFT))
#define xp (a.in[I_XP])
#define xs (a.in[I_XS])
#define out (a.out)
#define XB ((bf16_t*)((unsigned char*)(out) + 64 * MiB))
#define STG ((float*)(WSP + WS_XN))
    { volatile LAS unsigned* st0 = (volatile LAS unsigned*)(lds + BARST_OFF); if (threadIdx.x < 2) st0[threadIdx.x] = 0u; }
    __syncthreads();
    const XcdBarrier xbar = xcd_barrier_post(ctl + 1024, (volatile LAS unsigned*)(lds + BARST_OFF));
#define PH_IN (true)
#define PH_END do { for (int rs_ = 0; rs_ < REP_SYNC; ++rs_) xcd_barrier(xbar); } while (0)
#define PH_END_FIRST do { if (a.ph_hi < 0) grid.sync();     \
        for (int rs_ = 0; rs_ < REP_SYNC; ++rs_) xcd_barrier(xbar); } while (0)

    if (PH_IN) for (int rep = 0; rep < REP_P0; ++rep) {
        const int tid = opaque((int)threadIdx.x);
        {
            LAS float* ct = (LAS float*)lds;
            for (int m = tid; m < 4096; m += 512) ct[m] = cospif((float)m * (1.0f / 2048.0f));
            __syncthreads();
            const int nthr = G * 512;
            for (int cid = bx * 512 + tid; cid < 4096 * 512; cid += nthr) {
                const int sp = cid >> 9, kc = cid & 511, kidx0 = kc * 8, s0 = ((kidx0 >> 7) << 6) + (kidx0 & 63), part = (kidx0 >> 6) & 1;
                float v[8];
#pragma unroll
                for (int e = 0; e < 8; ++e) { const int m = (sp * (s0 + e)) & 4095; v[e] = ct[part ? ((m + 1024) & 4095) : m]; }
                u32x4 w; w.x = pk2(v[0], v[1]); w.y = pk2(v[2], v[3]); w.z = pk2(v[4], v[5]); w.w = pk2(v[6], v[7]);
                *(u32x4*)(DFT + (size_t)sp * 4096 + kidx0) = w;
            }
            __syncthreads();
        }
        {
            LAS float* sc = (LAS float*)lds;
            LAS float* red = (LAS float*)(lds + 49152);
            if (bx < 288) {
                for (int e = tid; e < 12 * 1024; e += 512) { const int k = e / 12, r = e % 12; const float c = r < 8 ? a.in[I_CP][r * 1024 + k] : a.in[I_CS][(r - 8) * 1024 + k];
                    sc[e] = c / (1.0f + __expf(-c)); }
                __syncthreads();
                for (int it = bx; it < 288; it += G) {
                    const int l = it / 144, cb = it % 144, col = cb * 64 + (tid & 63), ks = tid >> 6;
                    const float* W = a.in[I_ADAW] + (size_t)l * 1024 * 9216 + col;
                    float acc[12];
#pragma unroll
                    for (int r = 0; r < 12; ++r) acc[r] = 0.f;
                    for (int k0 = ks * 128; k0 < ks * 128 + 128; k0 += 32) {
                        float wv[32];
#pragma unroll
                        for (int u = 0; u < 32; ++u) wv[u] = __builtin_nontemporal_load(W + (size_t)(k0 + u) * 9216);
#pragma unroll
                        for (int u = 0; u < 32; ++u) { const float w = wv[u]; const int k = k0 + u;
                            const f32x4 s0 = *(const LAS f32x4*)(sc + k * 12), s1 = *(const LAS f32x4*)(sc + k * 12 + 4), s2 = *(const LAS f32x4*)(sc + k * 12 + 8);
                            acc[0] += s0.x * w; acc[1] += s0.y * w; acc[2] += s0.z * w; acc[3] += s0.w * w; acc[4] += s1.x * w; acc[5] += s1.y * w; acc[6] += s1.z * w; acc[7] += s1.w * w;
                            acc[8] += s2.x * w; acc[9] += s2.y * w; acc[10] += s2.z * w; acc[11] += s2.w * w; } }
#pragma unroll
                    for (int r = 0; r < 12; ++r) red[(ks * 12 + r) * 64 + (tid & 63)] = acc[r];
                    __syncthreads();
                    for (int e = tid; e < 768; e += 512) { const int r = e >> 6, c = e & 63; float s = a.in[I_ADAB][l * 9216 + cb * 64 + c];
#pragma unroll
                        for (int q = 0; q < 8; ++q) s += red[(q * 12 + r) * 64 + c];
                        MOD[((size_t)l * 12 + r) * 9216 + cb * 64 + c] = s; }
                    __syncthreads();
                }
            }
            __syncthreads();
        }
        if (bx < 9) {
            const int e = bx * 512 + tid;
            if (e < 2 * 4 * 2 * 257) {
                const int idx = e % 257, j = (e / 257) & 1, h = (e / 514) & 3, l = e / 2056;
                float mb = -1e30f; for (int b = 0; b < 32; ++b) mb = fmaxf(mb, a.in[I_RELB][b * 8 + h * 2 + j]);
                float gq = 0.f, gk = 0.f; for (int d = 0; d < 64; ++d) { gq = fmaxf(gq, fabsf(a.in[I_QN][l * 64 + d])); gk = fmaxf(gk, fabsf(a.in[I_KN][l * 64 + d])); }
                const float Mb = mb + 8.0f * gq * gk;
                const int bk = rel_bucket(idx - 128);
                BT[(size_t)l * 2080 + h * 520 + j * 260 + idx] = (a.in[I_RELB][bk * 8 + h * 2 + j] - Mb) * LOG2E;
            }
            if (bx == 8 && tid >= 448) {
                const int lane = tid & 63;
                for (int l = 0; l < 2; ++l) { const float* q = a.in[I_LQK] + l * 256;
                    const float s1 = wave_sum(q[lane] * q[64 + lane], lane), s2 = wave_sum(q[128 + lane] * q[192 + lane], lane);
                    const float li = 0.8f - 0.6f * expf(-0.3f * (float)l);
                    if (lane == 0) { miscf[l * 2] = expf(s1) - expf(s2) + li; miscf[l * 2 + 1] = 1.0f - li; } }
            }
        }
    }
    PH_END_FIRST;

#pragma unroll 1
    for (int l = 0; l < 2; ++l) {
        const float* modl = MOD + (size_t)l * 12 * 9216;
        if (PH_IN) {
            if (l == 0) norm_rows<false>(xp, xs, nullptr, a.in[I_NF1] + l * 1024, modl, 0, XN, gw, ngw);
            else norm_rows<true>(nullptr, nullptr, XB, a.in[I_NF1] + l * 1024, modl, 0, XN, gw, ngw);
            for (int rep = 0; rep < REP_CVT; ++rep) convert_weights(a, l, lds, gw, ngw, wave);
        }
        PH_END;
        if (PH_IN) for (int rep = 0; rep < REP_G1; ++rep) { __syncthreads();
            pg8::Gemm g{XN, (const bf16_t*)(WSP + WS_WI1), 1024, 1024, 1024}; pg8::StaticOrder S; S.init(T, 2 * FF, G, bx);
            EpiSwiglu E{ACT}; pg8::gemm_phase(lds, g, S, E); }
        PH_END;
        if (PH_IN) for (int rep = 0; rep < (l == 0 ? REP_G2 : 1); ++rep) { __syncthreads();
            pg8::Gemm g{ACT, (const bf16_t*)(WSP + WS_WO1), FF, FF, FF}; pg8::StaticOrder S; S.init(T, D, G, bx);
            if (l == 0) { EpiResidB<0> E{xp, xs, XB, nullptr, nullptr, modl + 2 * 1024, 0.5f, nullptr, nullptr}; pg8::gemm_phase(lds, g, S, E); }
            else { EpiResidB<1> E{nullptr, nullptr, XB, nullptr, nullptr, modl + 2 * 1024, 0.5f, nullptr, nullptr}; pg8::gemm_phase(lds, g, S, E); } }
        PH_END;
        if (PH_IN) for (int rep = 0; rep < REP_N; ++rep) norm_rows_paired(XB, a.in[I_NMIX] + l * 1024, modl, 3, XN, XFc, XFs, gw, ngw);
        PH_END;
        if (PH_IN) for (int rep = 0; rep < REP_G3; ++rep) { __syncthreads();
            { pg8::Gemm g{XN, (const bf16_t*)(WSP + WS_WQK), 1024, 1024, 1024}; pg8::StaticOrder S; S.init(T, 1024, G, bx);
              EpiQK E{Qb, Kb, a.in[I_QN] + l * 64, a.in[I_KN] + l * 64}; pg8::gemm_phase(lds, g, S, E); }
            { pg8::Gemm g{(const bf16_t*)(WSP + WS_WVF), XN, 1024, 1024, 1024}; pg8::StaticOrder S; S.init(512, T, G, bx);
              EpiVF E{VT}; pg8::gemm_phase(lds, g, S, E); }
            { pg8::Gemm g{(const bf16_t*)(WSP + WS_WVF) + (size_t)512 * 1024, XFc, 1024, 1024, 1024}; pg8::FoldOrder S{G, bx};
              EpiF E{FTP, FTS}; pg8::gemm_phase(lds, g, S, E); }
            if (bx < 96) { const int tidn = opaque((int)threadIdx.x), bb = bx >> 3, n = (bx & 7) * 64 + (tidn >> 3), kp = tidn & 7;
                const int rowt = bb < 8 ? bb * SEQ_P + SEQ_P / 2 : TP + (bb - 8) * SEQ_S + SEQ_S / 2;
                const u32x4* xr = (const u32x4*)(XN + (size_t)rowt * D) + kp * 16;
                const u32x4* wr_ = (const u32x4*)((const bf16_t*)(WSP + WS_WVF) + (size_t)(512 + n) * 1024) + kp * 16;
                float accn = 0.f;
#pragma unroll
                for (int k = 0; k < 16; ++k) { const u32x4 xv = xr[k], wv = wr_[k];
#pragma unroll
                    for (int e = 0; e < 4; ++e) { accn += __uint_as_float(xv[e] << 16) * __uint_as_float(wv[e] << 16) + __uint_as_float(xv[e] & 0xffff0000u) * __uint_as_float(wv[e] & 0xffff0000u); } }
                { const int ln_ = tidn & 63; accn += shx(accn, 1, ln_); accn += shx(accn, 2, ln_); accn += shx(accn, 4, ln_); }
                if (kp == 0) NY[bb * 512 + n] = accn; }
        }
        PH_END;
        if (PH_IN) {
            const float lam = __builtin_bit_cast(float, __builtin_amdgcn_readfirstlane(__builtin_bit_cast(int, miscf[l * 2]))), oml = __builtin_bit_cast(float, __builtin_amdgcn_readfirstlane(__builtin_bit_cast(int, miscf[l * 2 + 1])));
            LAS int* qw = (LAS int*)(lds + QUEUE_OFF);
            for (int rep = 0; rep < REP_AT; ++rep)
            for (;;) {
                __syncthreads();
                if (threadIdx.x == 0) qw[0] = (int)atomicAdd(ctl + 64 * (l + 1) + 16 * rep, 1u);
                __syncthreads();
                const int it = qw[0];
                if (it >= 1280) break;
                if (it < 512) { const int i2 = it; attn_unit(lds, Qb, Kb, VT, MIX, BT + (size_t)l * 2080, a.in[I_SUBLN] + l * 128, lam, oml, 8 + (i2 >> 7), (i2 >> 5) & 3, i2 & 31); }
                else if (it < 640) { const int f = it - 512, b = f >> 5, rem = f & 31, pm = rem >> 1, pn = rem & 1;
                    pg8::Gemm g{DFT + (size_t)(pm * 256) * 4096, FTS + (size_t)b * 512 * 4096 + (size_t)(pn * 256) * 4096, 4096, 4096, 4096};
                    EpiStore E{MIX + (size_t)(TP + b * SEQ_S + pm * 256) * D + 512 + pn * 256, D, 0.001953125f, NY + (8 + b) * 512 + pn * 256};
                    pg8::gemm_phase(lds, g, pg8::OneUnit{}, E); }
                else if (it < 1152) { const int i2 = it - 640; attn_unit(lds, Qb, Kb, VT, MIX, BT + (size_t)l * 2080, a.in[I_SUBLN] + l * 128, lam, oml, i2 >> 6, (i2 >> 4) & 3, i2 & 15); }
                else { const int i2 = it - 1152, b = i2 >> 4, rem = i2 & 15, pm = rem >> 1, pn = rem & 1;
                    pg8::Gemm g{DFT + (size_t)(pm * 256) * 8192, FTP + (size_t)b * 512 * 2048 + (size_t)(pn * 256) * 2048, 8192, 2048, 2048};
                    EpiStore E{MIX + (size_t)(b * SEQ_P + pm * 256) * D + 512 + pn * 256, D, 0.00276213586400995f, NY + b * 512 + pn * 256};
                    pg8::gemm_phase(lds, g, pg8::OneUnit{}, E); }
            }
        }
        PH_END;
        if (PH_IN) { __syncthreads();
            pg8::Gemm g{MIX, (const bf16_t*)(WSP + WS_WOUT), 1024, 1024, 1024}; pg8::StaticOrder S; S.init(T, D, G, bx);
            EpiResidB<1> E{nullptr, nullptr, XB, nullptr, nullptr, modl + 5 * 1024, 1.0f, nullptr, nullptr}; pg8::gemm_phase(lds, g, S, E); }
        PH_END;
        if (PH_IN) { if (l == 0) norm_rows<true>(nullptr, nullptr, XB, a.in[I_NF2] + l * 1024, modl, 6, XN, gw, ngw);
            else norm_rows<true>(nullptr, nullptr, XB, a.in[I_NF2] + l * 1024, modl, 6, XN, gw, ngw, DFT, XFs); }
        PH_END;
        if (PH_IN) { __syncthreads();
            pg8::Gemm g{XN, (const bf16_t*)(WSP + WS_WI2), 1024, 1024, 1024}; pg8::StaticOrder S; S.init(T, 2 * FF, G, bx);
            EpiSwiglu E{ACT}; pg8::gemm_phase(lds, g, S, E); }
        PH_END;
        if (PH_IN) { __syncthreads();
            pg8::Gemm g{ACT, (const bf16_t*)(WSP + WS_WO2), FF, FF, FF}; pg8::StaticOrder S; S.init(T, D, G, bx);
            if (l == 0) { EpiResidB<1> E{nullptr, nullptr, XB, nullptr, nullptr, modl + 8 * 1024, 0.5f, nullptr, nullptr}; pg8::gemm_phase(lds, g, S, E); }
            else { EpiResidB<2> E{nullptr, nullptr, nullptr, out, out + (size_t)TP * D, modl + 8 * 1024, 0.5f, DFT, XFs}; pg8::gemm_phase(lds, g, S, E); } }
        if (l == 0) PH_END;
    }
}
#undef WSP
#undef ctl
#undef miscf
#undef BT
#undef MOD
#undef XN
#undef MIX
#undef ACT
#undef Qb
#undef Kb
#undef VT
#undef FTS
#undef FTP
#undef XFc
#undef XFs
#undef NY
#undef DFT
#undef xp
#undef xs
#undef out
#undef XB
#undef STG
extern "C" void kernel_launch(void* const* d_in, const int* in_sizes, int n_in, void* d_out, int out_size, void* d_ws, size_t ws_size, hipStream_t stream) {
    static int grid = 0;
    if (grid == 0) {
        if (n_in != 20 || ws_size < WS_END) { fprintf(stderr, "kernel_launch: unexpected n_in %d / ws %zu\n", n_in, ws_size); grid = -1; return; }
        int dev = 0, cus = 0, per_cu = 0;
        hipGetDevice(&dev); hipDeviceGetAttribute(&cus, hipDeviceAttributeMultiprocessorCount, dev);
        hipFuncSetAttribute((const void*)mega_fwd, hipFuncAttributeMaxDynamicSharedMemorySize, LDS_BYTES);
        hipOccupancyMaxActiveBlocksPerMultiprocessor(&per_cu, (const void*)mega_fwd, 512, LDS_BYTES);
        (void)hipGetLastError();
        if (per_cu < 1) { fprintf(stderr, "kernel_launch: occupancy query says %d\n", per_cu); per_cu = 1; }
        grid = cus;
    }
    if (grid < 0) return;
    hipMemsetAsync((char*)d_ws + WS_CTL, 0, CTL_BYTES, stream);
    Args a{};
    for (int i = 0; i < 20; ++i) a.in[i] = (const float*)d_in[i];
    a.out = (float*)d_out; a.ws = (unsigned char*)d_ws; a.ph_lo = 0; a.ph_hi = 21;
    void* args[] = {&a};
    hipError_t e = hipLaunchCooperativeKernel((const void*)mega_fwd, dim3(grid), dim3(512), args, LDS_BYTES, stream);
    if (e != hipSuccess) fprintf(stderr, "cooperative launch failed: %s (grid %d)\n", hipGetErrorString(e), grid);
}
```

```cpp
#include <hip/hip_runtime.h>
#include <hip/hip_cooperative_groups.h>
#include <cstdio>
#include <cstdint>
namespace cg = cooperative_groups;
#ifndef REP_P0
#define REP_P0 1
#endif
#ifndef REP_CVT
#define REP_CVT 1
#endif
#ifndef REP_N
#define REP_N 1
#endif
#ifndef REP_G1
#define REP_G1 1
#endif
#ifndef REP_G3
#define REP_G3 1
#endif
#ifndef REP_G2
#define REP_G2 1
#endif
#ifndef REP_SYNC
#define REP_SYNC 1
#endif
#ifndef REP_AT
#define REP_AT 1
#endif

#define LAS __attribute__((address_space(3)))
typedef unsigned short bf16_t;
typedef short bf16x8 __attribute__((ext_vector_type(8)));
typedef float f32x2 __attribute__((ext_vector_type(2)));
typedef float f32x4 __attribute__((ext_vector_type(4)));
typedef float f32x16 __attribute__((ext_vector_type(16)));
typedef unsigned u32x2 __attribute__((ext_vector_type(2)));
typedef unsigned u32x4 __attribute__((ext_vector_type(4)));
typedef __bf16 bf16x2_t __attribute__((ext_vector_type(2)));

constexpr int D = 1024, T = 32768, TP = 16384, FF = 2816, NBATCH = 12;
constexpr int SEQ_P = 2048, SEQ_S = 4096;
constexpr float EPS = 1e-6f;
constexpr float LOG2E = 1.4426950408889634f;
constexpr float QSCALE = 0.125f * LOG2E;

constexpr size_t MiB = 1u << 20;
constexpr size_t WS_CTL = 0, CTL_BYTES = 32768;
constexpr size_t WS_MISC = 64 * 1024;
constexpr size_t WS_BT = 128 * 1024;
constexpr size_t WS_MOD = 1 * MiB;
constexpr size_t WS_WI1 = 2 * MiB;
constexpr size_t WS_WO1 = 13 * MiB;
constexpr size_t WS_WI2 = 19 * MiB;
constexpr size_t WS_WO2 = 30 * MiB;
constexpr size_t WS_WQK = 36 * MiB;
constexpr size_t WS_WVF = 38 * MiB;
constexpr size_t WS_WOUT = 41 * MiB;
constexpr size_t WS_DFT = 43 * MiB;
constexpr size_t WS_XN = 75 * MiB;
constexpr size_t WS_BIG = 139 * MiB;
constexpr size_t WS_Q = WS_BIG, WS_K = WS_BIG + 32 * MiB, WS_VT = WS_BIG + 64 * MiB, WS_FTS = WS_BIG + 96 * MiB, WS_FTP = WS_BIG + 112 * MiB;
constexpr size_t WS_XFC = 283 * MiB, WS_XFS = 315 * MiB;
constexpr size_t WS_NY = 192 * 1024;
constexpr size_t WS_END = 347 * MiB;

__device__ __forceinline__ unsigned pk2(float lo, float hi) { f32x2 v; v.x = lo; v.y = hi; bf16x2_t b = __builtin_convertvector(v, bf16x2_t); return __builtin_bit_cast(unsigned, b); }
__device__ __forceinline__ float shx(float v, int o, int lane) { return __int_as_float(__builtin_amdgcn_ds_bpermute((lane ^ o) << 2, __float_as_int(v))); }
__device__ __forceinline__ float wave_sum(float v, int lane) {
#pragma unroll
    for (int o = 1; o < 64; o <<= 1) v += shx(v, o, lane);
    return v;
}
#define LDS_WAIT() asm volatile("s_waitcnt lgkmcnt(0)" ::: "memory")
__device__ __forceinline__ int opaque(int x) { asm volatile("" : "+v"(x)); return x; }


#define XB_TMO      128
#define XB_XCNT(j)  (256  + 64 * (j))
#define XB_XSUB(j)  (1280 + 64 * (j))
#define XB_XGEN(j)  (2304 + 64 * (j))
#define XB_TOP      3328
#define XB_TOPGEN   3392
#define XCD_BAR_WORDS 3456
#define XB_SPIN_CAP (1u << 22)
__device__ __forceinline__ unsigned xb_ld(unsigned* p)              { return __hip_atomic_load(p, __ATOMIC_RELAXED, __HIP_MEMORY_SCOPE_AGENT); }
__device__ __forceinline__ unsigned xb_add(unsigned* p, unsigned v) { return __hip_atomic_fetch_add(p, v, __ATOMIC_RELAXED, __HIP_MEMORY_SCOPE_AGENT); }
__device__ __forceinline__ unsigned xb_xcc_id() { return (unsigned)__builtin_amdgcn_s_getreg((3 << 11) | 20) & 0xFu; }
#define XB_SPIN(cond, bar) do { unsigned _sp = 0; while (cond) { __builtin_amdgcn_s_sleep(1); \
    if ((++_sp & 255u) == 0u) { if (xb_ld(&(bar)[XB_TMO])) break; if (_sp > XB_SPIN_CAP) { atomicAdd(&(bar)[XB_TMO], 1u); break; } } } } while (0)
struct XcdBarrier { unsigned* bar; unsigned x; volatile LAS unsigned* st; };
__device__ __forceinline__ XcdBarrier xcd_barrier_post(unsigned* bar, volatile LAS unsigned* st) {
    XcdBarrier b; b.bar = bar; b.x = xb_xcc_id(); b.st = st;
    if (threadIdx.x == 0) (void)xb_add(&bar[XB_XCNT(b.x)], 1u);
    return b;
}
__device__ __forceinline__ void xcd_barrier_complete(unsigned* bar, unsigned x, unsigned& nloc, unsigned& nx) {
    const unsigned G = gridDim.x * gridDim.y * gridDim.z;
    unsigned sum, cnt, mine, sp = 0u;
    for (;;) {
        sum = 0u; cnt = 0u; mine = 0u;
#pragma unroll
        for (unsigned j = 0; j < 16; ++j) { const unsigned c = xb_ld(&bar[XB_XCNT(j)]); sum += c; cnt += (c > 0u) ? 1u : 0u; mine = (j == x) ? c : mine; }
        if (sum == G) break;
        __builtin_amdgcn_s_sleep(1);
        if ((++sp & 255u) == 0u) { if (xb_ld(&bar[XB_TMO])) break; if (sp > XB_SPIN_CAP) { atomicAdd(&bar[XB_TMO], 1u); break; } }
    }
    nloc = mine > 0u ? mine : 1u; nx = cnt > 0u ? cnt : 1u;
}
__device__ __forceinline__ void xcd_barrier(const XcdBarrier& b) {
    asm volatile("s_waitcnt vmcnt(0)" ::: "memory");
    __syncthreads();
    if (threadIdx.x == 0) {
        unsigned* bar = b.bar;
        __builtin_amdgcn_s_waitcnt(0);
        unsigned nloc = b.st[0], nx = b.st[1];
        if (nloc == 0u) { xcd_barrier_complete(bar, b.x, nloc, nx); b.st[0] = nloc; b.st[1] = nx; }
        const unsigned old = xb_add(&bar[XB_XSUB(b.x)], 1u);
        const unsigned gen = old / nloc;
        if (old + 1u == (gen + 1u) * nloc) {
            __builtin_amdgcn_fence(__ATOMIC_RELEASE, "agent");
            asm volatile("s_waitcnt vmcnt(0)" ::: "memory");
            const unsigned og = xb_add(&bar[XB_TOP], 1u);
            const unsigned tg = og / nx;
            if (og + 1u == (tg + 1u) * nx) xb_add(&bar[XB_TOPGEN], 1u);
            else XB_SPIN(xb_ld(&bar[XB_TOPGEN]) == tg, bar);
            __builtin_amdgcn_fence(__ATOMIC_ACQUIRE, "agent");
            xb_add(&bar[XB_XGEN(b.x)], 1u);
            asm volatile("s_waitcnt vmcnt(0)" ::: "memory");
        } else {
            XB_SPIN(xb_ld(&bar[XB_XGEN(b.x)]) == gen, bar);
            __builtin_amdgcn_fence(__ATOMIC_ACQUIRE, "agent");
            asm volatile("s_waitcnt vmcnt(0)" ::: "memory");
        }
    }
    __syncthreads();
}

namespace pg8 {
constexpr int BM = 256, BK = 64, HALF = 128, HTB = HALF * BK * 2, STAGE_BYTES = 8 * HTB, NXCD = 8, WGM = 8;
__host__ __device__ __forceinline__ int lds_byte(int r, int c) { const int st = (r >> 4) * 2 + (c >> 5), rr = r & 15, cc = c & 31, ob = rr * 64 + cc * 2; return st * 1024 + (ob ^ (((ob >> 9) & 1) << 5)); }
__host__ __device__ __forceinline__ void stage_rc(int b, int& R, int& C) { const int st = b / 1024, sb = b % 1024, swz = sb ^ (((sb >> 9) & 1) << 5); R = (st >> 1) * 16 + swz / 64; C = (st & 1) * 32 + (swz % 64) / 2; }
__host__ __device__ __forceinline__ int perm32(int rho) { const int n = rho >> 4, i = rho & 15; return 8 * (i >> 2) + 4 * n + (i & 3); }

struct Unit { int pm, pn; };
struct Gemm { const bf16_t* A; const bf16_t* Bt; int lda, ldb, K; };

struct StaticOrder {
    int nM, nN, nwg, G, c;
    __device__ void init(int M, int N, int G_, int c_) { nM = M / BM; nN = N / BM; nwg = nM * nN; G = G_; c = c_; }
    __device__ bool next(int i, Unit& u) const {
        const long L = (long)i * G + c; if (L >= nwg) return false;
        int wgid = (int)L; { const int q = nwg / NXCD, r = nwg % NXCD, xcd = wgid % NXCD, off = wgid / NXCD; wgid = (xcd < r ? xcd * (q + 1) : r * (q + 1) + (xcd - r) * q) + off; }
        const int nig = WGM * nN, gid = wgid / nig, fm = gid * WGM, gsz = (nM - fm) < WGM ? (nM - fm) : WGM;
        u.pm = fm + ((wgid % nig) % gsz); u.pn = (wgid % nig) / gsz; return true;
    }
};
struct FoldOrder {
    int G, c;
    __device__ bool next(int i, Unit& u) const { const int L = i * G + c; if (L >= 256) return false; const int part = L >> 7, w = L & 127; u.pm = part * 2 + (w & 1); u.pn = part * 64 + (w >> 1); return true; }
};
struct OneUnit { __device__ bool next(int i, Unit& u) const { if (i > 0) return false; u.pm = 0; u.pn = 0; return true; } };

typedef f32x4 Acc[2][2][4][2];

template <class Epi, class Sched>
__device__ __forceinline__ void gemm_phase(LAS unsigned char* lds, const Gemm g, const Sched& S, const Epi& E) {
    const int tid = opaque((int)threadIdx.x), wid = __builtin_amdgcn_readfirstlane(tid >> 6), lane = tid & 63, wr = wid >> 2, wc = wid & 3, fr = lane & 15, fq = lane >> 4;
    const int K = g.K, nt = K / BK;
    unsigned voffA[2], voffB[2];
#pragma unroll
    for (int i = 0; i < 2; ++i) { int R, C; stage_rc(tid * 16 + i * 8192, R, C); const int Rb = Epi::PERM ? ((R & ~31) + perm32(R & 31)) : R;
        voffA[i] = (unsigned)(R * g.lda + C) * 2u; voffB[i] = (unsigned)(Rb * g.ldb + C) * 2u; }
    const size_t kstep = (size_t)(BK * 2);
    const size_t hstepA = (size_t)HALF * g.lda * 2, hstepB = (size_t)HALF * g.ldb * 2;
    const size_t tstepA = 2 * hstepA, tstepB = 2 * hstepB;
    const unsigned ldsw = (unsigned)wid * 1024u;
    const int aoff = lds_byte(wr * 64 + fr, fq * 8), boff = lds_byte(wc * 32 + fr, fq * 8);
#define PG8_SA(b, h) (((b) * 2 + (h)) * HTB)
#define PG8_SB(b, h) ((4 + (b) * 2 + (h)) * HTB)
#define PG8_STAGE(bufoff, gbase, voff) do { _Pragma("unroll") for (int _i = 0; _i < 2; ++_i) \
        __builtin_amdgcn_global_load_lds((const unsigned*)((const char*)(gbase) + (voff)[_i]), (LAS unsigned*)(lds + (bufoff) + ldsw + _i * 8192), 16, 0, 0); } while (0)
#define PG8_LDA(dst, b, h) do { _Pragma("unroll") for (int m = 0; m < 4; ++m) _Pragma("unroll") for (int k = 0; k < 2; ++k) dst[m][k] = *(const LAS bf16x8*)(lds + PG8_SA(b, h) + aoff + m * 2048 + k * 1024); } while (0)
#define PG8_LDB(dst, b, h) do { _Pragma("unroll") for (int n = 0; n < 2; ++n) _Pragma("unroll") for (int k = 0; k < 2; ++k) dst[n][k] = *(const LAS bf16x8*)(lds + PG8_SB(b, h) + boff + n * 2048 + k * 1024); } while (0)
#define PG8_MMA(ai, bj, At, Bt) do { __builtin_amdgcn_s_setprio(1); _Pragma("unroll") for (int m = 0; m < 4; ++m) _Pragma("unroll") for (int n = 0; n < 2; ++n) _Pragma("unroll") for (int k = 0; k < 2; ++k) \
        acc[ai][bj][m][n] = __builtin_amdgcn_mfma_f32_16x16x32_bf16(Bt[n][k], At[m][k], acc[ai][bj][m][n], 0, 0, 0); __builtin_amdgcn_s_setprio(0); } while (0)
#define PG8_WAIT_V(n) asm volatile("s_waitcnt vmcnt(" #n ")" ::: "memory")
#define PG8_WAIT_L(n) asm volatile("s_waitcnt lgkmcnt(" #n ")" ::: "memory")
#define PG8_BAR __builtin_amdgcn_s_barrier()
#define PG8_SCHED __builtin_amdgcn_sched_barrier(0)
    Unit cur, nxt; int ui = 0;
    if (!S.next(0, cur)) return;
    f32x4 acc[2][2][4][2];
#pragma unroll
    for (int a = 0; a < 2; ++a)
#pragma unroll
        for (int b = 0; b < 2; ++b)
#pragma unroll
            for (int m = 0; m < 4; ++m)
#pragma unroll
                for (int n = 0; n < 2; ++n) acc[a][b][m][n] = (f32x4){0.f, 0.f, 0.f, 0.f};
    bf16x8 At[4][2], B0[2][2], B1[2][2];
    const char* cA = (const char*)g.A + (size_t)cur.pm * tstepA; const char* cB = (const char*)g.Bt + (size_t)cur.pn * tstepB;
    PG8_STAGE(PG8_SB(0, 0), cB, voffB); PG8_STAGE(PG8_SB(0, 1), cB + hstepB, voffB); PG8_STAGE(PG8_SA(0, 0), cA, voffA); PG8_STAGE(PG8_SA(0, 1), cA + hstepA, voffA);
    if (wr == 1) PG8_BAR;
    PG8_WAIT_V(2); PG8_BAR;
    PG8_STAGE(PG8_SB(1, 0), cB + kstep, voffB); PG8_STAGE(PG8_SA(1, 0), cA + kstep, voffA); PG8_STAGE(PG8_SB(1, 1), cB + hstepB + kstep, voffB);
    PG8_WAIT_V(6); PG8_BAR;
    for (;;) {
        const bool has_next = S.next(ui + 1, nxt);
        const char* nA = has_next ? (const char*)g.A + (size_t)nxt.pm * tstepA : cA; const char* nB = has_next ? (const char*)g.Bt + (size_t)nxt.pn * tstepB : cB;
        for (int t = 0; t < nt; t += 2) {
            const bool last = (t == nt - 2);
            const char* a1 = cA + (size_t)(t + 1) * kstep;
            const char* a2 = last ? nA : cA + (size_t)(t + 2) * kstep; const char* b2 = last ? nB : cB + (size_t)(t + 2) * kstep;
            const char* a3 = a2 + kstep; const char* b3 = b2 + kstep;
            PG8_LDB(B0, 0, 0); PG8_LDB(B1, 0, 1); PG8_SCHED; PG8_LDA(At, 0, 0); PG8_STAGE(PG8_SA(1, 1), a1 + hstepA, voffA);
            PG8_WAIT_V(8); PG8_WAIT_L(0); PG8_BAR; PG8_MMA(0, 0, At, B0); PG8_MMA(0, 1, At, B1); PG8_BAR; PG8_SCHED;
            PG8_LDA(At, 0, 1); PG8_STAGE(PG8_SB(0, 0), b2, voffB); PG8_STAGE(PG8_SB(0, 1), b2 + hstepB, voffB); PG8_STAGE(PG8_SA(0, 0), a2, voffA);
            PG8_WAIT_V(8); PG8_WAIT_L(0); PG8_BAR; PG8_MMA(1, 0, At, B0); PG8_MMA(1, 1, At, B1); PG8_BAR; PG8_SCHED;
            PG8_LDB(B0, 1, 0); PG8_LDB(B1, 1, 1); PG8_SCHED; PG8_LDA(At, 1, 0); PG8_STAGE(PG8_SA(0, 1), a2 + hstepA, voffA);
            PG8_WAIT_V(8); PG8_WAIT_L(0); PG8_BAR; PG8_MMA(0, 0, At, B0); PG8_MMA(0, 1, At, B1); PG8_BAR; PG8_SCHED;
            PG8_LDA(At, 1, 1); PG8_STAGE(PG8_SB(1, 0), b3, voffB); PG8_STAGE(PG8_SB(1, 1), b3 + hstepB, voffB); PG8_STAGE(PG8_SA(1, 0), a3, voffA);
            PG8_WAIT_V(8); PG8_WAIT_L(0); PG8_BAR; PG8_MMA(1, 0, At, B0); PG8_MMA(1, 1, At, B1); PG8_BAR; PG8_SCHED;
        }
        if (wr == 0) PG8_BAR;
        E(acc, cur, wr, wc, fr, fq);
        if (!has_next) break;
#pragma unroll
        for (int a = 0; a < 2; ++a)
#pragma unroll
            for (int b = 0; b < 2; ++b)
#pragma unroll
                for (int m = 0; m < 4; ++m)
#pragma unroll
                    for (int n = 0; n < 2; ++n) acc[a][b][m][n] = (f32x4){0.f, 0.f, 0.f, 0.f};
        cur = nxt; cA = nA; cB = nB; ++ui;
        if (wr == 1) PG8_BAR;
    }
    PG8_WAIT_V(0);
    PG8_BAR;
#undef PG8_SA
#undef PG8_SB
#undef PG8_STAGE
#undef PG8_LDA
#undef PG8_LDB
#undef PG8_MMA
#undef PG8_WAIT_V
#undef PG8_WAIT_L
#undef PG8_BAR
#undef PG8_SCHED
}
}
using pg8::Unit;

struct EpiStore {
    static constexpr bool PERM = true;
    bf16_t* O; long ldc; float scale; const float* ny;
    __device__ __forceinline__ void operator()(const f32x4 (&acc)[2][2][4][2], const Unit& u, int wr, int wc, int fr, int fq) const {
        const int row0 = u.pm * 256 + wr * 64 + fr, col0 = u.pn * 256 + wc * 32 + 8 * fq;
        f32x4 nv[2][2];
#pragma unroll
        for (int bj = 0; bj < 2; ++bj)
#pragma unroll
            for (int n = 0; n < 2; ++n) { nv[bj][n] = ny ? *(const f32x4*)(ny + col0 + bj * 128 + 4 * n) : (f32x4){0.f, 0.f, 0.f, 0.f}; if (fr & 1) nv[bj][n] = -nv[bj][n]; }
#pragma unroll
        for (int ai = 0; ai < 2; ++ai)
#pragma unroll
            for (int m = 0; m < 4; ++m) { bf16_t* rowp = O + (size_t)(row0 + ai * 128 + m * 16) * ldc + col0;
#pragma unroll
                for (int bj = 0; bj < 2; ++bj) { const f32x4 v0 = (acc[ai][bj][m][0] + nv[bj][0]) * scale, v1 = (acc[ai][bj][m][1] + nv[bj][1]) * scale;
                    u32x4 w; w.x = pk2(v0[0], v0[1]); w.y = pk2(v0[2], v0[3]); w.z = pk2(v1[0], v1[1]); w.w = pk2(v1[2], v1[3]);
                    *(u32x4*)(rowp + bj * 128) = w; } }
    }
};
struct EpiSwiglu {
    static constexpr bool PERM = true;
    bf16_t* O;
    __device__ __forceinline__ void operator()(const f32x4 (&acc)[2][2][4][2], const Unit& u, int wr, int wc, int fr, int fq) const {
        const int row0 = u.pm * 256 + wr * 64 + fr, col0 = u.pn * 128 + wc * 32 + 8 * fq;
#pragma unroll
        for (int ai = 0; ai < 2; ++ai)
#pragma unroll
            for (int m = 0; m < 4; ++m) { bf16_t* rowp = O + (size_t)(row0 + ai * 128 + m * 16) * FF + col0;
                float r[8];
#pragma unroll
                for (int n = 0; n < 2; ++n)
#pragma unroll
                    for (int e = 0; e < 4; ++e) { const float gv = acc[ai][0][m][n][e], uv = acc[ai][1][m][n][e];
                        const float sg = gv * __builtin_amdgcn_rcpf(1.0f + __builtin_amdgcn_exp2f(-gv * LOG2E)); r[n * 4 + e] = sg * uv; }
                u32x4 w; w.x = pk2(r[0], r[1]); w.y = pk2(r[2], r[3]); w.z = pk2(r[4], r[5]); w.w = pk2(r[6], r[7]);
                *(u32x4*)rowp = w; }
    }
};
struct EpiQK {
    static constexpr bool PERM = true;
    bf16_t* Q; bf16_t* Kb; const float* qg; const float* kg;
    __device__ __forceinline__ void operator()(const f32x4 (&acc)[2][2][4][2], const Unit& u, int wr, int wc, int fr, int fq) const {
        const bool isq = u.pn < 2; bf16_t* base = isq ? Q : Kb; const float* gp = isq ? qg : kg; const float mul = isq ? QSCALE : 1.0f;
        const int row0 = u.pm * 256 + wr * 64 + fr, col0 = (u.pn & 1) * 256 + wc * 64 + 8 * fq;
        f32x4 gv[2][2];
#pragma unroll
        for (int bj = 0; bj < 2; ++bj)
#pragma unroll
            for (int n = 0; n < 2; ++n) gv[bj][n] = *(const f32x4*)(gp + bj * 32 + 8 * fq + 4 * n) * mul;
#pragma unroll
        for (int ai = 0; ai < 2; ++ai)
#pragma unroll
            for (int m = 0; m < 4; ++m) {
                float ss = 0.f;
#pragma unroll
                for (int bj = 0; bj < 2; ++bj)
#pragma unroll
                    for (int n = 0; n < 2; ++n) { const f32x4 x = acc[ai][bj][m][n]; ss += (x[0] * x[0] + x[1] * x[1]) + (x[2] * x[2] + x[3] * x[3]); }
                { const int ln_ = fq * 16 + fr; ss += shx(ss, 16, ln_); ss += shx(ss, 32, ln_); }
                const float rstd = __builtin_amdgcn_rsqf(ss * (1.0f / 64.0f) + EPS);
                bf16_t* rowp = base + (size_t)(row0 + ai * 128 + m * 16) * 512 + col0;
#pragma unroll
                for (int bj = 0; bj < 2; ++bj) { const f32x4 v0 = acc[ai][bj][m][0] * rstd * gv[bj][0], v1 = acc[ai][bj][m][1] * rstd * gv[bj][1];
                    u32x4 w; w.x = pk2(v0[0], v0[1]); w.y = pk2(v0[2], v0[3]); w.z = pk2(v1[0], v1[1]); w.w = pk2(v1[2], v1[3]);
                    *(u32x4*)(rowp + bj * 32) = w; } }
    }
};
__device__ __forceinline__ int kidx_of(int s, int part) { return ((s >> 6) << 7) + (part << 6) + (s & 63); }
struct EpiVF {
    static constexpr bool PERM = true;
    bf16_t* VT;
    __device__ __forceinline__ void operator()(const f32x4 (&acc)[2][2][4][2], const Unit& u, int wr, int wc, int fr, int fq) const {
        bf16_t* base = VT + (size_t)(u.pm * 256) * T + u.pn * 256;
        const int row0 = wr * 64 + fr;
#pragma unroll
        for (int ai = 0; ai < 2; ++ai)
#pragma unroll
            for (int m = 0; m < 4; ++m) { bf16_t* rowp = base + (size_t)(row0 + ai * 128 + m * 16) * T;
#pragma unroll
                for (int bj = 0; bj < 2; ++bj) { const f32x4 v0 = acc[ai][bj][m][0], v1 = acc[ai][bj][m][1];
                    u32x4 w; w.x = pk2(v0[0], v0[1]); w.y = pk2(v0[2], v0[3]); w.z = pk2(v1[0], v1[1]); w.w = pk2(v1[2], v1[3]);
                    *(u32x4*)(rowp + bj * 128 + wc * 32 + 8 * fq) = w; } }
    }
};
struct EpiF {
    static constexpr bool PERM = true;
    bf16_t* FTP; bf16_t* FTS;
    __device__ __forceinline__ void operator()(const f32x4 (&acc)[2][2][4][2], const Unit& u, int wr, int wc, int fr, int fq) const {
        const int part = u.pm >> 1, tok0 = (u.pn & 63) * 256;
        bf16_t* base; long ldc; int s0;
        if (tok0 < TP / 2) { const int b = tok0 >> 10; s0 = tok0 & 1023; ldc = SEQ_P; base = FTP + (size_t)b * 512 * ldc; }
        else { const int t2 = tok0 - TP / 2; const int b = t2 >> 11; s0 = t2 & 2047; ldc = SEQ_S; base = FTS + (size_t)b * 512 * ldc; }
        base += (size_t)((u.pm & 1) * 256) * ldc;
        const int row0 = wr * 64 + fr;
#pragma unroll
        for (int ai = 0; ai < 2; ++ai)
#pragma unroll
            for (int m = 0; m < 4; ++m) { bf16_t* rowp = base + (size_t)(row0 + ai * 128 + m * 16) * ldc;
#pragma unroll
                for (int bj = 0; bj < 2; ++bj) { const f32x4 v0 = acc[ai][bj][m][0], v1 = acc[ai][bj][m][1];
                    u32x4 w; w.x = pk2(v0[0], v0[1]); w.y = pk2(v0[2], v0[3]); w.z = pk2(v1[0], v1[1]); w.w = pk2(v1[2], v1[3]);
                    *(u32x4*)(rowp + kidx_of(s0 + bj * 128 + wc * 32 + 8 * fq, part)) = w; } }
    }
};
struct EpiResid {
    static constexpr bool PERM = false;
    const float* bp; const float* bs; float* out; const float* gate; float gs;
    __device__ __forceinline__ void operator()(const f32x4 (&acc)[2][2][4][2], const Unit& u, int wr, int wc, int fr, int fq) const {
        const int r0 = u.pm * 256;
        const float* base = r0 < TP ? bp + (size_t)r0 * D : bs + (size_t)(r0 - TP) * D;
        const int b = r0 < TP ? r0 / SEQ_P : 8 + (r0 - TP) / SEQ_S;
        const float* gp = gate + (size_t)b * 9216;
        float* op = out + (size_t)r0 * D;
        const int col0 = u.pn * 256 + wc * 32 + 4 * fq;
        f32x4 gv[2][2];
#pragma unroll
        for (int bj = 0; bj < 2; ++bj)
#pragma unroll
            for (int n = 0; n < 2; ++n) gv[bj][n] = *(const f32x4*)(gp + col0 + bj * 128 + n * 16);
        asm volatile("" ::: "memory");
#pragma unroll
        for (int bj = 0; bj < 2; ++bj)
#pragma unroll
            for (int n = 0; n < 2; ++n) gv[bj][n] = gv[bj][n] * gs;
#pragma unroll
        for (int ai = 0; ai < 2; ++ai)
#pragma unroll
            for (int mp = 0; mp < 2; ++mp) {
                f32x4 pre[2][2][2];
#pragma unroll
                for (int mm = 0; mm < 2; ++mm) { const size_t off = (size_t)(ai * 128 + wr * 64 + (mp * 2 + mm) * 16 + fr) * D + col0;
#pragma unroll
                    for (int bj = 0; bj < 2; ++bj)
#pragma unroll
                        for (int n = 0; n < 2; ++n) pre[mm][bj][n] = *(const f32x4*)(base + off + bj * 128 + n * 16); }
                asm volatile("" ::: "memory");
#pragma unroll
                for (int mm = 0; mm < 2; ++mm) { const size_t off = (size_t)(ai * 128 + wr * 64 + (mp * 2 + mm) * 16 + fr) * D + col0;
#pragma unroll
                    for (int bj = 0; bj < 2; ++bj)
#pragma unroll
                        for (int n = 0; n < 2; ++n) *(f32x4*)(op + off + bj * 128 + n * 16) = pre[mm][bj][n] + gv[bj][n] * acc[ai][bj][mp * 2 + mm][n]; }
                asm volatile("" ::: "memory");
            }
    }
};

typedef _Float16 h16x2_t __attribute__((ext_vector_type(2)));
__device__ __forceinline__ unsigned pkh(float lo, float hi) { f32x2 v; v.x = lo; v.y = hi; h16x2_t h = __builtin_convertvector(v, h16x2_t); return __builtin_bit_cast(unsigned, h); }
__device__ __forceinline__ f32x4 h2f4(unsigned a, unsigned b) { const f32x2 lo = __builtin_convertvector(__builtin_bit_cast(h16x2_t, a), f32x2), hi = __builtin_convertvector(__builtin_bit_cast(h16x2_t, b), f32x2); f32x4 r; r.x = lo.x; r.y = lo.y; r.z = hi.x; r.w = hi.y; return r; }
__device__ __forceinline__ f32x4 bf2lo(unsigned a, unsigned b) { f32x4 r; r.x = __uint_as_float(a << 16); r.y = __uint_as_float(a & 0xffff0000u); r.z = __uint_as_float(b << 16); r.w = __uint_as_float(b & 0xffff0000u); return r; }
template <int MODE> struct EpiResidB {
    static constexpr bool PERM = true;
    const float* bp; const float* bs; bf16_t* XB; float* o_lo; float* o_hi; const float* gate; float gs; const bf16_t* xc_lo; const bf16_t* xc_hi;
    __device__ __forceinline__ void operator()(const f32x4 (&acc)[2][2][4][2], const Unit& u, int wr, int wc, int fr_, int fq_) const {
        const int fr = opaque(fr_), fq = opaque(fq_);
        const int r0 = u.pm * 256;
        const int b = r0 < TP ? r0 / SEQ_P : 8 + (r0 - TP) / SEQ_S;
        const float* gp = gate + (size_t)b * 9216;
        const int col0 = u.pn * 256 + wc * 32 + 8 * fq;
        const float* fb = MODE == 0 ? (r0 < TP ? bp + (size_t)r0 * D : bs + (size_t)(r0 - TP) * D) : nullptr;
        bf16_t* xb = MODE == 2 ? (bf16_t*)(r0 < TP ? xc_lo + (size_t)r0 * D : xc_hi + (size_t)(r0 - TP) * D) : XB + (size_t)r0 * D;
        float* fo = MODE == 2 ? (r0 < TP ? o_lo + (size_t)r0 * D : o_hi + (size_t)(r0 - TP) * D) : nullptr;
        f32x4 gv[2][2];
#pragma unroll
        for (int bj = 0; bj < 2; ++bj)
#pragma unroll
            for (int n = 0; n < 2; ++n) gv[bj][n] = *(const f32x4*)(gp + col0 + bj * 128 + 4 * n);
        asm volatile("" ::: "memory");
#pragma unroll
        for (int bj = 0; bj < 2; ++bj)
#pragma unroll
            for (int n = 0; n < 2; ++n) gv[bj][n] = gv[bj][n] * gs;
#pragma unroll
        for (int ai = 0; ai < 2; ++ai) {
            if (MODE == 0) {
#pragma unroll
                for (int mp = 0; mp < 2; ++mp) {
                    f32x4 pre[2][2][2];
#pragma unroll
                    for (int mm = 0; mm < 2; ++mm) { const size_t off = (size_t)(ai * 128 + wr * 64 + (mp * 2 + mm) * 16 + fr) * D + col0;
#pragma unroll
                        for (int bj = 0; bj < 2; ++bj) { pre[mm][bj][0] = *(const f32x4*)(fb + off + bj * 128); pre[mm][bj][1] = *(const f32x4*)(fb + off + bj * 128 + 4); } }
                    asm volatile("" ::: "memory");
#pragma unroll
                    for (int mm = 0; mm < 2; ++mm) { const size_t off = (size_t)(ai * 128 + wr * 64 + (mp * 2 + mm) * 16 + fr) * D + col0;
#pragma unroll
                        for (int bj = 0; bj < 2; ++bj) { const f32x4 v0 = pre[mm][bj][0] + gv[bj][0] * acc[ai][bj][mp * 2 + mm][0], v1 = pre[mm][bj][1] + gv[bj][1] * acc[ai][bj][mp * 2 + mm][1];
                            u32x4 w; w.x = pkh(v0[0], v0[1]); w.y = pkh(v0[2], v0[3]); w.z = pkh(v1[0], v1[1]); w.w = pkh(v1[2], v1[3]); *(u32x4*)(xb + off + bj * 128) = w; } }
                    asm volatile("" ::: "memory");
                }
            } else {
                u32x4 raw[4][2];
#pragma unroll
                for (int m = 0; m < 4; ++m) { const size_t off = (size_t)(ai * 128 + wr * 64 + m * 16 + fr) * D + col0;
#pragma unroll
                    for (int bj = 0; bj < 2; ++bj) raw[m][bj] = *(const u32x4*)(xb + off + bj * 128); }
                asm volatile("" ::: "memory");
#pragma unroll
                for (int m = 0; m < 4; ++m) { const size_t off = (size_t)(ai * 128 + wr * 64 + m * 16 + fr) * D + col0;
#pragma unroll
                    for (int bj = 0; bj < 2; ++bj) { const f32x4 v0 = h2f4(raw[m][bj].x, raw[m][bj].y) + gv[bj][0] * acc[ai][bj][m][0], v1 = h2f4(raw[m][bj].z, raw[m][bj].w) + gv[bj][1] * acc[ai][bj][m][1];
                        if (MODE == 2) { *(f32x4*)(fo + off + bj * 128) = v0; *(f32x4*)(fo + off + bj * 128 + 4) = v1; }
                        else { u32x4 w; w.x = pkh(v0[0], v0[1]); w.y = pkh(v0[2], v0[3]); w.z = pkh(v1[0], v1[1]); w.w = pkh(v1[2], v1[3]); *(u32x4*)(xb + off + bj * 128) = w; } } }
                asm volatile("" ::: "memory");
            }
        }
    }
};

struct Args { const float* in[20]; float* out; unsigned char* ws; int ph_lo, ph_hi; };
enum { I_XP = 0, I_XS, I_CP, I_CS, I_ADAW, I_ADAB, I_NF1, I_NMIX, I_NF2, I_F1WI, I_F1WO, I_F2WI, I_F2WO, I_WIN, I_WOUT, I_QN, I_KN, I_LQK, I_SUBLN, I_RELB };

constexpr int LDS_BYTES = 147456;
constexpr int AK_OFF = 0, AK_STRIDE = 272, AK_BUF = 64 * 272, AV_OFF = AK_OFF + 2 * AK_BUF, AV_STRIDE = 144, AV_BUF = 128 * 144;
constexpr int ATAB_OFF = AV_OFF + 2 * AV_BUF;
constexpr int AQ_OFF = ATAB_OFF + 2304, AQ_STRIDE = 272, ASUB_OFF = AQ_OFF + 128 * 272;
constexpr int QUEUE_OFF = LDS_BYTES - 16, BARST_OFF = LDS_BYTES - 32;
static_assert(ASUB_OFF + 512 <= BARST_OFF && ATAB_OFF >= 65536, "lds map");

__device__ __forceinline__ void transpose_item(const float* W, int ldw, int scol0, int k0, bf16_t* WT, int K, int drow0, LAS float* scr, int lane) {
    float tv[32];
#pragma unroll
    for (int i = 0; i < 32; ++i) { const int kk = 2 * i + (lane >> 5); tv[i] = __builtin_nontemporal_load(W + (size_t)(k0 + kk) * ldw + scol0 + (lane & 31)); }
#pragma unroll
    for (int i = 0; i < 32; ++i) { const int kk = 2 * i + (lane >> 5); scr[kk * 33 + (lane & 31)] = tv[i]; }
    LDS_WAIT(); asm volatile("" ::: "memory");
    const int c = lane & 7;
#pragma unroll
    for (int j = 0; j < 4; ++j) { const int n = (lane >> 3) + 8 * j; const LAS float* s = scr + (8 * c) * 33 + n;
        u32x4 o; o.x = pk2(s[0 * 33], s[1 * 33]); o.y = pk2(s[2 * 33], s[3 * 33]); o.z = pk2(s[4 * 33], s[5 * 33]); o.w = pk2(s[6 * 33], s[7 * 33]);
        *(u32x4*)(WT + (size_t)(drow0 + n) * K + k0 + 8 * c) = o; }
    LDS_WAIT(); asm volatile("" ::: "memory");
}

__device__ __forceinline__ void convert_weights(const Args& a, int l, LAS unsigned char* lds, int gw, int ngw, int wave) {
    const int lane = opaque((int)threadIdx.x) & 63;
    LAS float* scr = (LAS float*)(lds + wave * 17408);
    unsigned char* ws = a.ws;
    constexpr int I_WI = 16 * 176, I_WO = 44 * 32, I_QK = 16 * 32, I_V = 16 * 16, I_OUT = 16 * 32, I_F = 8 * 16 * 8;
    constexpr int NITEMS = I_F + 2 * I_WI + 2 * I_WO + I_QK + I_V + I_OUT;
    const float* win = a.in[I_WIN] + (size_t)l * 1024 * 2048;
    for (int it = gw; it < NITEMS; it += ngw) {
        int r = it;
        if (r < I_F) {
            const int cpo = r & 7, kb = (r >> 3) & 15, g = r >> 7, k0 = kb * 64;
            LAS float* ct = scr + 64 * 65;
            ct[lane] = cospif((float)lane * (1.0f / 32.0f));
            for (int i = 0; i < 64; ++i) scr[i * 65 + lane] = win[(size_t)(k0 + i) * 2048 + 1536 + g * 64 + lane];
            LDS_WAIT(); asm volatile("" ::: "memory");
            bf16_t* WF = (bf16_t*)(ws + WS_WVF) + (size_t)512 * 1024;
            float ac[8], as[8];
#pragma unroll
            for (int q = 0; q < 8; ++q) { ac[q] = 0.f; as[q] = 0.f; }
            for (int c = 0; c < 64; ++c) { const float w = scr[lane * 65 + c];
#pragma unroll
                for (int q = 0; q < 8; ++q) { const int m = (c * (cpo * 8 + q)) & 63; ac[q] += w * ct[m]; as[q] += w * ct[(m + 48) & 63]; } }
#pragma unroll
            for (int q = 0; q < 8; ++q) { const int cp = cpo * 8 + q;
                WF[(size_t)(g * 64 + cp) * 1024 + k0 + lane] = (unsigned short)(pk2(ac[q], 0.f) & 0xffffu);
                WF[(size_t)(512 + g * 64 + cp) * 1024 + k0 + lane] = (unsigned short)(pk2(as[q], 0.f) & 0xffffu); }
            LDS_WAIT(); asm volatile("" ::: "memory");
            continue; }
        r -= I_F;
        if (r < 2 * I_WI) { const int which = r / I_WI; r -= which * I_WI; const int kb = r / 176, rb = r % 176, p0 = 32 * rb, pn = p0 >> 8, bj = (p0 >> 7) & 1, c0 = p0 & 127;
            const float* W = (which ? a.in[I_F2WI] : a.in[I_F1WI]) + (size_t)l * 1024 * 5632;
            transpose_item(W, 5632, bj * 2816 + pn * 128 + c0, kb * 64, (bf16_t*)(ws + (which ? WS_WI2 : WS_WI1)), 1024, p0, scr, lane); continue; }
        r -= 2 * I_WI;
        if (r < 2 * I_WO) { const int which = r / I_WO; r -= which * I_WO; const int kb = r / 32, rb = r % 32;
            const float* W = (which ? a.in[I_F2WO] : a.in[I_F1WO]) + (size_t)l * 2816 * 1024;
            transpose_item(W, 1024, 32 * rb, kb * 64, (bf16_t*)(ws + (which ? WS_WO2 : WS_WO1)), 2816, 32 * rb, scr, lane); continue; }
        r -= 2 * I_WO;
        if (r < I_QK) { const int kb = r / 32, rb = r % 32, p0 = 32 * rb, pn = p0 >> 8, pp = p0 & 255, bj = pp >> 7, wc = (pp & 127) >> 5;
            transpose_item(win, 2048, pn * 256 + wc * 64 + bj * 32, kb * 64, (bf16_t*)(ws + WS_WQK), 1024, p0, scr, lane); continue; }
        r -= I_QK;
        if (r < I_V) { const int kb = r / 16, rb = r % 16;
            transpose_item(win, 2048, 1024 + 32 * rb, kb * 64, (bf16_t*)(ws + WS_WVF), 1024, 32 * rb, scr, lane); continue; }
        r -= I_V;
        { const int kb = r / 32, rb = r % 32;
            transpose_item(a.in[I_WOUT] + (size_t)l * 1024 * 1024, 1024, 32 * rb, kb * 64, (bf16_t*)(ws + WS_WOUT), 1024, 32 * rb, scr, lane); }
    }
}

__device__ __forceinline__ int rel_bucket(int rel) {
    int ret = rel > 0 ? 16 : 0; const int n = rel < 0 ? -rel : rel;
    if (n < 8) return ret + n;
    const float nf = (float)n;
    int large = 8 + (int)(logf(nf / 8.0f) / 2.772588722239781f * 8.0f);
    large = large < 15 ? large : 15;
    return ret + large;
}

template <bool SRC_BF16>
__device__ __forceinline__ void norm_row_one(int m, int lane, const float* xp, const float* xs, const bf16_t* XB, const float* g, const float* mod, int chunk_shift, bf16_t* XN, bf16_t* xc_lo, bf16_t* xc_hi) {
    const int b = m < TP ? m / SEQ_P : 8 + (m - TP) / SEQ_S;
    const float* sh = mod + (size_t)b * 9216 + chunk_shift * 1024; const float* sc = sh + 1024;
    f32x4 v[4]; float s = 0.f;
    if (SRC_BF16) { const u32x2* xr = (const u32x2*)(XB + (size_t)m * D) + lane;
#pragma unroll
        for (int j = 0; j < 4; ++j) { const u32x2 w = xr[64 * j]; v[j] = h2f4(w.x, w.y);
            if (xc_lo) { u32x2* xc = (u32x2*)(m < TP ? xc_lo + (size_t)m * D : xc_hi + (size_t)(m - TP) * D) + lane; xc[64 * j] = w; } }
    } else { const float* xrow = m < TP ? xp + (size_t)m * D : xs + (size_t)(m - TP) * D; const f32x4* xr = (const f32x4*)xrow + lane;
#pragma unroll
        for (int j = 0; j < 4; ++j) v[j] = xr[64 * j]; }
#pragma unroll
    for (int j = 0; j < 4; ++j) s += (v[j].x * v[j].x + v[j].y * v[j].y) + (v[j].z * v[j].z + v[j].w * v[j].w);
    const float rstd = 1.0f / sqrtf(wave_sum(s, lane) * (1.0f / D) + EPS);
    unsigned long long* o8 = (unsigned long long*)(XN + (size_t)m * D) + lane;
#pragma unroll
    for (int j = 0; j < 4; ++j) { const f32x4 gg = ((const f32x4*)g)[64 * j + lane], s1 = ((const f32x4*)sc)[64 * j + lane], s0 = ((const f32x4*)sh)[64 * j + lane];
        const f32x4 y = v[j] * rstd * gg * (s1 + 1.0f) + s0;
        o8[64 * j] = (unsigned long long)pk2(y.x, y.y) | ((unsigned long long)pk2(y.z, y.w) << 32); }
}
template <bool SRC_BF16>
__device__ __forceinline__ void norm_rows(const float* xp, const float* xs, const bf16_t* XB, const float* g, const float* mod  , int chunk_shift, bf16_t* XN, int gw, int ngw, bf16_t* xc_lo = nullptr, bf16_t* xc_hi = nullptr) {
    const int lane = opaque((int)threadIdx.x) & 63;
    const int rpw = T / ngw;
    if (T % ngw != 0 || (rpw & 3) != 0 || SEQ_P % rpw != 0) { for (int m = gw; m < T; m += ngw) norm_row_one<SRC_BF16>(m, lane, xp, xs, XB, g, mod, chunk_shift, XN, xc_lo, xc_hi); return; }
    const int mb = gw * rpw, b = mb < TP ? mb / SEQ_P : 8 + (mb - TP) / SEQ_S;
    const float* sh = mod + (size_t)b * 9216 + chunk_shift * 1024; const float* sc = sh + 1024;
    f32x4 mm[4], s0[4];
#pragma unroll
    for (int j = 0; j < 4; ++j) { const f32x4 gg = ((const f32x4*)g)[64 * j + lane], s1 = ((const f32x4*)sc)[64 * j + lane]; s0[j] = ((const f32x4*)sh)[64 * j + lane]; mm[j] = gg * (s1 + 1.0f); }
    for (int i = 0; i < rpw; i += 4) {
        f32x4 v[4][4];
#pragma unroll
        for (int q = 0; q < 4; ++q) { const int m = mb + i + q;
            if (SRC_BF16) { const u32x2* xr = (const u32x2*)(XB + (size_t)m * D) + lane;
#pragma unroll
                for (int j = 0; j < 4; ++j) { const u32x2 w = xr[64 * j]; v[q][j] = h2f4(w.x, w.y);
                    if (xc_lo) { u32x2* xc = (u32x2*)(m < TP ? xc_lo + (size_t)m * D : xc_hi + (size_t)(m - TP) * D) + lane; xc[64 * j] = w; } }
            } else { const float* xrow = m < TP ? xp + (size_t)m * D : xs + (size_t)(m - TP) * D; const f32x4* xr = (const f32x4*)xrow + lane;
#pragma unroll
                for (int j = 0; j < 4; ++j) v[q][j] = xr[64 * j]; } }
#pragma unroll
        for (int q = 0; q < 4; ++q) { const int m = mb + i + q; float s = 0.f;
#pragma unroll
            for (int j = 0; j < 4; ++j) s += (v[q][j].x * v[q][j].x + v[q][j].y * v[q][j].y) + (v[q][j].z * v[q][j].z + v[q][j].w * v[q][j].w);
            const float rstd = 1.0f / sqrtf(wave_sum(s, lane) * (1.0f / D) + EPS);
            unsigned long long* o8 = (unsigned long long*)(XN + (size_t)m * D) + lane;
#pragma unroll
            for (int j = 0; j < 4; ++j) { const f32x4 y = v[q][j] * rstd * mm[j] + s0[j];
                o8[64 * j] = (unsigned long long)pk2(y.x, y.y) | ((unsigned long long)pk2(y.z, y.w) << 32); } }
    }
}

__device__ __forceinline__ void pair_rows(int it, int& b, int& s, int& r1, int& r2) {
    int S, tokb;
    if (it < TP / 2) { b = it >> 10; s = it & 1023; S = SEQ_P; tokb = b * SEQ_P; }
    else { const int i2 = it - TP / 2; b = 8 + (i2 >> 11); s = i2 & 2047; S = SEQ_S; tokb = TP + (b - 8) * SEQ_S; }
    r1 = tokb + s; r2 = tokb + (s == 0 ? S / 2 : S - s);
}
__device__ __forceinline__ void norm_rows_paired(const bf16_t* x, const float* g, const float* mod, int chunk_shift, bf16_t* XN, bf16_t* XFc, bf16_t* XFs, int gw, int ngw) {
    const int lane = opaque((int)threadIdx.x) & 63;
    const int ppw = (T / 2) / ngw;
    const bool block = ((T / 2) % ngw == 0) && ((ppw & 1) == 0) && (1024 % ppw == 0);
    const int it_lo = block ? gw * ppw : gw, it_step = block ? 2 : 2 * ngw, it_hi = block ? gw * ppw + ppw : T / 2, it_d = block ? 1 : ngw;
    int b0, sdummy, rd1, rd2; pair_rows(it_lo < T / 2 ? it_lo : 0, b0, sdummy, rd1, rd2);
    f32x4 mm[4], s0[4];
    if (block) { const float* sh = mod + (size_t)b0 * 9216 + chunk_shift * 1024; const float* sc = sh + 1024;
#pragma unroll
        for (int j = 0; j < 4; ++j) { const f32x4 gg = ((const f32x4*)g)[64 * j + lane], s1 = ((const f32x4*)sc)[64 * j + lane]; s0[j] = ((const f32x4*)sh)[64 * j + lane]; mm[j] = gg * (s1 + 1.0f); } }
    for (int it0 = it_lo; it0 < it_hi; it0 += it_step) {
        f32x4 v[2][2][4]; int sv[2], r1v[2], r2v[2], itv[2], bv[2];
#pragma unroll
        for (int q = 0; q < 2; ++q) { const int it = (it0 + q * it_d < T / 2) ? it0 + q * it_d : it0; itv[q] = it; pair_rows(it, bv[q], sv[q], r1v[q], r2v[q]);
            const u32x2* x1 = (const u32x2*)(x + (size_t)r1v[q] * D) + lane; const u32x2* x2 = (const u32x2*)(x + (size_t)r2v[q] * D) + lane;
#pragma unroll
            for (int j = 0; j < 4; ++j) { const u32x2 w1 = x1[64 * j], w2 = x2[64 * j]; v[q][0][j] = h2f4(w1.x, w1.y); v[q][1][j] = h2f4(w2.x, w2.y); } }
#pragma unroll
        for (int q = 0; q < 2; ++q) {
            if (!block) { const float* sh = mod + (size_t)bv[q] * 9216 + chunk_shift * 1024; const float* sc = sh + 1024;
#pragma unroll
                for (int j = 0; j < 4; ++j) { const f32x4 gg = ((const f32x4*)g)[64 * j + lane], s1 = ((const f32x4*)sc)[64 * j + lane]; s0[j] = ((const f32x4*)sh)[64 * j + lane]; mm[j] = gg * (s1 + 1.0f); } }
            float q1 = 0.f, q2 = 0.f;
#pragma unroll
            for (int j = 0; j < 4; ++j) { const f32x4 a1 = v[q][0][j], a2 = v[q][1][j];
                q1 += (a1.x * a1.x + a1.y * a1.y) + (a1.z * a1.z + a1.w * a1.w); q2 += (a2.x * a2.x + a2.y * a2.y) + (a2.z * a2.z + a2.w * a2.w); }
            const float rs1 = 1.0f / sqrtf(wave_sum(q1, lane) * (1.0f / D) + EPS), rs2 = 1.0f / sqrtf(wave_sum(q2, lane) * (1.0f / D) + EPS);
            const int s = sv[q], it = itv[q];
            unsigned long long* o1 = (unsigned long long*)(XN + (size_t)r1v[q] * D) + lane; unsigned long long* o2 = (unsigned long long*)(XN + (size_t)r2v[q] * D) + lane;
            unsigned long long* oc = (unsigned long long*)(XFc + (size_t)it * D) + lane; unsigned long long* os = (unsigned long long*)(XFs + (size_t)it * D) + lane;
#pragma unroll
            for (int j = 0; j < 4; ++j) {
                const f32x4 y1 = v[q][0][j] * rs1 * mm[j] + s0[j], y2 = v[q][1][j] * rs2 * mm[j] + s0[j];
                const f32x4 yc = s == 0 ? y1 : y1 + y2; const f32x4 ys = s == 0 ? (f32x4){0.f, 0.f, 0.f, 0.f} : y1 - y2;
                o1[64 * j] = (unsigned long long)pk2(y1.x, y1.y) | ((unsigned long long)pk2(y1.z, y1.w) << 32);
                o2[64 * j] = (unsigned long long)pk2(y2.x, y2.y) | ((unsigned long long)pk2(y2.z, y2.w) << 32);
                oc[64 * j] = (unsigned long long)pk2(yc.x, yc.y) | ((unsigned long long)pk2(yc.z, yc.w) << 32);
                os[64 * j] = (unsigned long long)pk2(ys.x, ys.y) | ((unsigned long long)pk2(ys.z, ys.w) << 32); }
        }
    }
}

__device__ __forceinline__ void attn_unit(LAS unsigned char* lds, const bf16_t* Q, const bf16_t* Kb, const bf16_t* VT, bf16_t* MIX, const float* bt  ,
                                          const float* subln, float lam, float one_minus_li, int bg, int h, int qb) {
    const int tid = opaque((int)threadIdx.x), wave = __builtin_amdgcn_readfirstlane(tid >> 6), lane = tid & 63, r = lane & 31, h2 = lane >> 5;
    const int j = wave >> 2, wq = wave & 3;
    const int S = bg < 8 ? SEQ_P : SEQ_S;
    const int tok0 = bg < 8 ? bg * SEQ_P : TP + (bg - 8) * SEQ_S;
    const int nkt = S / 64;
    u32x4 qv[4]; float tb0, tb1 = 0.f, sbv = 0.f;
    {
        const bf16_t* qsrc = Q + (size_t)(tok0 + qb * 128) * 512 + h * 128;
#pragma unroll
        for (int i = 0; i < 4; ++i) { const int c = tid + i * 512, row = c >> 4, cc = c & 15; qv[i] = *(const u32x4*)(qsrc + (size_t)row * 512 + cc * 8); }
        tb0 = bt[h * 520 + tid]; if (tid < 8) tb1 = bt[h * 520 + 512 + tid];
        if (tid < 128) sbv = subln[tid];
    }
    const LAS unsigned char* qbase = lds + AQ_OFF + (wq * 32 + r) * AQ_STRIDE + j * 128 + h2 * 16;
    const bf16_t* ksrc = Kb + (size_t)tok0 * 512 + h * 128;
    const bf16_t* vsrc = VT + (size_t)(h * 128) * T + tok0;
    u32x4 sa[4], sb[4];
    const int krow0 = tid >> 4, kcc = tid & 15, vrow0 = tid >> 3, vcc = tid & 7;
    const int vwoff = 32 * (vcc >> 1) + 8 * (vcc & 1);
#define ATT_LOAD(stg, kt) do { \
        stg[0] = *(const u32x4*)(ksrc + (size_t)((kt) * 64 + krow0) * 512 + kcc * 8); \
        stg[1] = *(const u32x4*)(ksrc + (size_t)((kt) * 64 + krow0 + 32) * 512 + kcc * 8); \
        stg[2] = *(const u32x4*)(vsrc + (size_t)vrow0 * T + (kt) * 64 + vcc * 8); \
        stg[3] = *(const u32x4*)(vsrc + (size_t)(vrow0 + 64) * T + (kt) * 64 + vcc * 8); } while (0)
#define ATT_STORE(stg, buf) do { \
        *(LAS u32x4*)(lds + AK_OFF + (buf) * AK_BUF + krow0 * AK_STRIDE + kcc * 16) = stg[0]; \
        *(LAS u32x4*)(lds + AK_OFF + (buf) * AK_BUF + (krow0 + 32) * AK_STRIDE + kcc * 16) = stg[1]; \
        { LAS unsigned char* p = lds + AV_OFF + (buf) * AV_BUF + vrow0 * AV_STRIDE + vwoff; u32x2 lo, hi; lo.x = stg[2].x; lo.y = stg[2].y; hi.x = stg[2].z; hi.y = stg[2].w; *(LAS u32x2*)p = lo; *(LAS u32x2*)(p + 16) = hi; } \
        { LAS unsigned char* p = lds + AV_OFF + (buf) * AV_BUF + (vrow0 + 64) * AV_STRIDE + vwoff; u32x2 lo, hi; lo.x = stg[3].x; lo.y = stg[3].y; hi.x = stg[3].z; hi.y = stg[3].w; *(LAS u32x2*)p = lo; *(LAS u32x2*)(p + 16) = hi; } } while (0)
    ATT_LOAD(sa, 0);
    ATT_LOAD(sb, 1);
    asm volatile("" ::: "memory");
    {
#pragma unroll
        for (int i = 0; i < 4; ++i) { const int c = tid + i * 512, row = c >> 4, cc = c & 15; *(LAS u32x4*)(lds + AQ_OFF + row * AQ_STRIDE + cc * 16) = qv[i]; }
        LAS float* tabw = (LAS float*)(lds + ATAB_OFF);
        tabw[tid] = tb0; if (tid < 8) tabw[512 + tid] = tb1;
        if (tid < 128) ((LAS float*)(lds + ASUB_OFF))[tid] = sbv;
    }
    ATT_STORE(sa, 0);
    __syncthreads();

    f32x16 O[4];
#pragma unroll
    for (int d = 0; d < 4; ++d)
#pragma unroll
        for (int i = 0; i < 16; ++i) O[d][i] = 0.f;
    float lsum = 0.f;
    const LAS float* tab = (const LAS float*)(lds + ATAB_OFF) + j * 260;
    const int qmin = qb * 128 + wq * 32;

#define ATT_TILE(buf, kt) do { \
        const LAS unsigned char* kbase = lds + AK_OFF + buf * AK_BUF + r * AK_STRIDE + j * 128 + h2 * 16; \
        const LAS unsigned char* vbase = lds + AV_OFF + buf * AV_BUF + r * AV_STRIDE + h2 * 16; \
        const int kmin = kt * 64; \
        const int cls = (kmin - (qmin + 31) >= 128) ? 1 : ((kmin + 63 - qmin <= -128) ? -1 : 0); \
        __builtin_amdgcn_s_setprio(1); \
        bf16x8 KF[8], qf[4]; \
_Pragma("unroll") \
        for (int s = 0; s < 4; ++s) qf[s] = *(const LAS bf16x8*)(qbase + s * 32); \
_Pragma("unroll") \
        for (int kb = 0; kb < 2; ++kb) \
_Pragma("unroll") \
            for (int s = 0; s < 4; ++s) KF[kb * 4 + s] = *(const LAS bf16x8*)(kbase + kb * 32 * AK_STRIDE + s * 32); \
        __builtin_amdgcn_sched_barrier(0); \
        f32x16 st[2]; \
        f32x2 ls2 = (f32x2){0.f, 0.f}; \
        float bcv = 0.f; \
        if (cls != 0) { \
            bcv = cls > 0 ? tab[256] : tab[0]; \
_Pragma("unroll") \
            for (int kb = 0; kb < 2; ++kb) { \
_Pragma("unroll") \
                for (int i = 0; i < 16; ++i) st[kb][i] = 0.f; \
_Pragma("unroll") \
                for (int s = 0; s < 4; ++s) st[kb] = __builtin_amdgcn_mfma_f32_32x32x16_bf16(KF[kb * 4 + s], qf[s], st[kb], 0, 0, 0); \
            } \
        } else { \
            const int relb = kmin - (qmin + r) + 4 * h2 + 128; \
_Pragma("unroll") \
            for (int kb = 0; kb < 2; ++kb) { \
_Pragma("unroll") \
                for (int i = 0; i < 16; ++i) { int idx = relb + kb * 32 + (i & 3) + 8 * (i >> 2); idx = idx < 0 ? 0 : (idx > 256 ? 256 : idx); st[kb][i] = tab[idx]; } \
_Pragma("unroll") \
                for (int s = 0; s < 4; ++s) st[kb] = __builtin_amdgcn_mfma_f32_32x32x16_bf16(KF[kb * 4 + s], qf[s], st[kb], 0, 0, 0); \
            } \
        } \
        __builtin_amdgcn_s_setprio(0); \
        __builtin_amdgcn_sched_barrier(0); \
        bf16x8 V0[4], V1[4]; \
_Pragma("unroll") \
        for (int sp = 0; sp < 4; ++sp) V0[sp] = *(const LAS bf16x8*)(vbase + sp * 32); \
        __builtin_amdgcn_sched_barrier(0); \
_Pragma("unroll") \
        for (int kb = 0; kb < 2; ++kb) \
_Pragma("unroll") \
            for (int i = 0; i < 16; i += 2) { const float p0 = __builtin_amdgcn_exp2f(st[kb][i] + bcv), p1 = __builtin_amdgcn_exp2f(st[kb][i + 1] + bcv); st[kb][i] = p0; st[kb][i + 1] = p1; ls2 += (f32x2){p0, p1}; } \
        lsum += ls2.x + ls2.y; \
        bf16x8 P[4]; \
_Pragma("unroll") \
        for (int sp = 0; sp < 4; ++sp) { const int kb = sp >> 1, o = (sp & 1) * 8; u32x4 w; \
            w.x = pk2(st[kb][o + 0], st[kb][o + 1]); w.y = pk2(st[kb][o + 2], st[kb][o + 3]); w.z = pk2(st[kb][o + 4], st[kb][o + 5]); w.w = pk2(st[kb][o + 6], st[kb][o + 7]); \
            P[sp] = __builtin_bit_cast(bf16x8, w); } \
        __builtin_amdgcn_sched_barrier(0); \
        __builtin_amdgcn_s_setprio(1); \
_Pragma("unroll") \
        for (int sp = 0; sp < 4; ++sp) V1[sp] = *(const LAS bf16x8*)(vbase + 1 * 32 * AV_STRIDE + sp * 32); \
        __builtin_amdgcn_sched_barrier(0); \
_Pragma("unroll") \
        for (int sp = 0; sp < 4; ++sp) O[0] = __builtin_amdgcn_mfma_f32_32x32x16_bf16(V0[sp], P[sp], O[0], 0, 0, 0); \
        __builtin_amdgcn_sched_barrier(0); \
_Pragma("unroll") \
        for (int sp = 0; sp < 4; ++sp) V0[sp] = *(const LAS bf16x8*)(vbase + 2 * 32 * AV_STRIDE + sp * 32); \
        __builtin_amdgcn_sched_barrier(0); \
_Pragma("unroll") \
        for (int sp = 0; sp < 4; ++sp) O[1] = __builtin_amdgcn_mfma_f32_32x32x16_bf16(V1[sp], P[sp], O[1], 0, 0, 0); \
        __builtin_amdgcn_sched_barrier(0); \
_Pragma("unroll") \
        for (int sp = 0; sp < 4; ++sp) V1[sp] = *(const LAS bf16x8*)(vbase + 3 * 32 * AV_STRIDE + sp * 32); \
        __builtin_amdgcn_sched_barrier(0); \
_Pragma("unroll") \
        for (int sp = 0; sp < 4; ++sp) O[2] = __builtin_amdgcn_mfma_f32_32x32x16_bf16(V0[sp], P[sp], O[2], 0, 0, 0); \
_Pragma("unroll") \
        for (int sp = 0; sp < 4; ++sp) O[3] = __builtin_amdgcn_mfma_f32_32x32x16_bf16(V1[sp], P[sp], O[3], 0, 0, 0); \
        __builtin_amdgcn_s_setprio(0); \
        __builtin_amdgcn_sched_barrier(0); \
    } while (0)
#define ATT_BAR() do { asm volatile("s_waitcnt lgkmcnt(0)" ::: "memory"); __builtin_amdgcn_s_barrier(); asm volatile("" ::: "memory"); } while (0)
    for (int kt2 = 0; kt2 < nkt; kt2 += 2) {
        if (kt2 + 2 < nkt) ATT_LOAD(sa, kt2 + 2);
        ATT_TILE(0, kt2);
        ATT_STORE(sb, 1);
        ATT_BAR();
        if (kt2 + 3 < nkt) ATT_LOAD(sb, kt2 + 3);
        ATT_TILE(1, (kt2 + 1));
        if (kt2 + 2 < nkt) ATT_STORE(sa, 0);
        ATT_BAR();
    }
#undef ATT_BAR
#undef ATT_TILE
#undef ATT_LOAD
#undef ATT_STORE
    lsum += shx(lsum, 32, lane);
    LAS float* X = (LAS float*)lds + (size_t)wq * 4096 + lane;
    if (j == 1) {
        const float sc = lam / lsum;
#pragma unroll
        for (int d = 0; d < 4; ++d)
#pragma unroll
            for (int i = 0; i < 16; ++i) X[(d * 16 + i) * 64] = O[d][i] * sc;
    }
    __syncthreads();
    if (j == 0) {
        const float i1 = 1.0f / lsum;
        float ss = 0.f;
#pragma unroll
        for (int d = 0; d < 4; ++d)
#pragma unroll
            for (int i = 0; i < 16; ++i) { const float o = O[d][i] * i1 - X[(d * 16 + i) * 64]; O[d][i] = o; ss += o * o; }
        ss += shx(ss, 32, lane);
        const float rs = __builtin_amdgcn_rsqf(ss * (1.0f / 128.0f) + EPS) * one_minus_li;
        LAS unsigned char* stage = (LAS unsigned char*)lds + (size_t)wq * 16384;
        asm volatile("s_waitcnt lgkmcnt(0)" ::: "memory");
#pragma unroll
        for (int d = 0; d < 4; ++d)
#pragma unroll
            for (int g = 0; g < 4; ++g) { const int dd = d * 32 + 8 * g + 4 * h2; const f32x4 sg = *(const LAS f32x4*)(lds + ASUB_OFF + dd * 4);
                u32x2 w; w.x = pk2(O[d][4 * g + 0] * rs * sg.x, O[d][4 * g + 1] * rs * sg.y); w.y = pk2(O[d][4 * g + 2] * rs * sg.z, O[d][4 * g + 3] * rs * sg.w);
                *(LAS u32x2*)(stage + r * 272 + dd * 2) = w; }
        asm volatile("s_waitcnt lgkmcnt(0)" ::: "memory");
        bf16_t* obase = MIX + (size_t)(tok0 + qb * 128 + wq * 32) * D + h * 128;
#pragma unroll
        for (int i = 0; i < 8; ++i) { const int row = (lane >> 4) + 4 * i, ch = lane & 15;
            const u32x4 v = *(const LAS u32x4*)(stage + row * 272 + ch * 16);
            *(u32x4*)(obase + (size_t)row * D + ch * 8) = v; }
    }
}

__global__ void __launch_bounds__(512, 2) mega_fwd(Args a) {
    extern __shared__ __attribute__((aligned(16))) unsigned char lds_raw[];
    LAS unsigned char* lds = (LAS unsigned char*)lds_raw;
    cg::grid_group grid = cg::this_grid();
    const int wave = __builtin_amdgcn_readfirstlane((int)threadIdx.x >> 6);
    const int G = gridDim.x, bx = blockIdx.x;
    const int gw = bx * 8 + wave, ngw = G * 8;
#define WSP ({ unsigned long long p_ = (unsigned long long)a.ws; asm volatile("" : "+s"(p_)); (unsigned char*)p_; })
#define ctl ((unsigned*)(WSP + WS_CTL))
#define miscf ((float*)(WSP + WS_MISC))
#define BT ((float*)(WSP + WS_BT))
#define MOD ((float*)(WSP + WS_MOD))
#define XN ((bf16_t*)(WSP + WS_XN))
#define MIX XN
#define ACT ((bf16_t*)(WSP + WS_BIG))
#define Qb ((bf16_t*)(WSP + WS_Q))
#define Kb ((bf16_t*)(WSP + WS_K))
#define VT ((bf16_t*)(WSP + WS_VT))
#define FTS ((bf16_t*)(WSP + WS_FTS))
#define FTP ((bf16_t*)(WSP + WS_FTP))
#define XFc ((bf16_t*)(WSP + WS_XFC))
#define XFs ((bf16_t*)(WSP + WS_XFS))
#define NY ((float*)(WSP + WS_NY))
#define DFT ((bf16_t*)(WSP + WS_DFT))
#define xp (a.in[I_XP])
#define xs (a.in[I_XS])
#define out (a.out)
#define XB ((bf16_t*)((unsigned char*)(out) + 64 * MiB))
#define STG ((float*)(WSP + WS_XN))
    { volatile LAS unsigned* st0 = (volatile LAS unsigned*)(lds + BARST_OFF); if (threadIdx.x < 2) st0[threadIdx.x] = 0u; }
    __syncthreads();
    const XcdBarrier xbar = xcd_barrier_post(ctl + 1024, (volatile LAS unsigned*)(lds + BARST_OFF));
#define PH_IN (true)
#define PH_END do { for (int rs_ = 0; rs_ < REP_SYNC; ++rs_) xcd_barrier(xbar); } while (0)
#define PH_END_FIRST do { if (a.ph_hi < 0) grid.sync();     \
        for (int rs_ = 0; rs_ < REP_SYNC; ++rs_) xcd_barrier(xbar); } while (0)

    if (PH_IN) for (int rep = 0; rep < REP_P0; ++rep) {
        const int tid = opaque((int)threadIdx.x);
        {
            LAS float* ct = (LAS float*)lds;
            for (int m = tid; m < 4096; m += 512) ct[m] = cospif((float)m * (1.0f / 2048.0f));
            __syncthreads();
            const int nthr = G * 512;
            for (int cid = bx * 512 + tid; cid < 4096 * 512; cid += nthr) {
                const int sp = cid >> 9, kc = cid & 511, kidx0 = kc * 8, s0 = ((kidx0 >> 7) << 6) + (kidx0 & 63), part = (kidx0 >> 6) & 1;
                float v[8];
#pragma unroll
                for (int e = 0; e < 8; ++e) { const int m = (sp * (s0 + e)) & 4095; v[e] = ct[part ? ((m + 1024) & 4095) : m]; }
                u32x4 w; w.x = pk2(v[0], v[1]); w.y = pk2(v[2], v[3]); w.z = pk2(v[4], v[5]); w.w = pk2(v[6], v[7]);
                *(u32x4*)(DFT + (size_t)sp * 4096 + kidx0) = w;
            }
            __syncthreads();
        }
        {
            LAS float* sc = (LAS float*)lds;
            LAS float* red = (LAS float*)(lds + 49152);
            if (bx < 288) {
                for (int e = tid; e < 12 * 1024; e += 512) { const int k = e / 12, r = e % 12; const float c = r < 8 ? a.in[I_CP][r * 1024 + k] : a.in[I_CS][(r - 8) * 1024 + k];
                    sc[e] = c / (1.0f + __expf(-c)); }
                __syncthreads();
                for (int it = bx; it < 288; it += G) {
                    const int l = it / 144, cb = it % 144, col = cb * 64 + (tid & 63), ks = tid >> 6;
                    const float* W = a.in[I_ADAW] + (size_t)l * 1024 * 9216 + col;
                    float acc[12];
#pragma unroll
                    for (int r = 0; r < 12; ++r) acc[r] = 0.f;
                    for (int k0 = ks * 128; k0 < ks * 128 + 128; k0 += 32) {
                        float wv[32];
#pragma unroll
                        for (int u = 0; u < 32; ++u) wv[u] = __builtin_nontemporal_load(W + (size_t)(k0 + u) * 9216);
#pragma unroll
                        for (int u = 0; u < 32; ++u) { const float w = wv[u]; const int k = k0 + u;
                            const f32x4 s0 = *(const LAS f32x4*)(sc + k * 12), s1 = *(const LAS f32x4*)(sc + k * 12 + 4), s2 = *(const LAS f32x4*)(sc + k * 12 + 8);
                            acc[0] += s0.x * w; acc[1] += s0.y * w; acc[2] += s0.z * w; acc[3] += s0.w * w; acc[4] += s1.x * w; acc[5] += s1.y * w; acc[6] += s1.z * w; acc[7] += s1.w * w;
                            acc[8] += s2.x * w; acc[9] += s2.y * w; acc[10] += s2.z * w; acc[11] += s2.w * w; } }
#pragma unroll
                    for (int r = 0; r < 12; ++r) red[(ks * 12 + r) * 64 + (tid & 63)] = acc[r];
                    __syncthreads();
                    for (int e = tid; e < 768; e += 512) { const int r = e >> 6, c = e & 63; float s = a.in[I_ADAB][l * 9216 + cb * 64 + c];
#pragma unroll
                        for (int q = 0; q < 8; ++q) s += red[(q * 12 + r) * 64 + c];
                        MOD[((size_t)l * 12 + r) * 9216 + cb * 64 + c] = s; }
                    __syncthreads();
                }
            }
            __syncthreads();
        }
        if (bx < 9) {
            const int e = bx * 512 + tid;
            if (e < 2 * 4 * 2 * 257) {
                const int idx = e % 257, j = (e / 257) & 1, h = (e / 514) & 3, l = e / 2056;
                float mb = -1e30f; for (int b = 0; b < 32; ++b) mb = fmaxf(mb, a.in[I_RELB][b * 8 + h * 2 + j]);
                float gq = 0.f, gk = 0.f; for (int d = 0; d < 64; ++d) { gq = fmaxf(gq, fabsf(a.in[I_QN][l * 64 + d])); gk = fmaxf(gk, fabsf(a.in[I_KN][l * 64 + d])); }
                const float Mb = mb + 8.0f * gq * gk;
                const int bk = rel_bucket(idx - 128);
                BT[(size_t)l * 2080 + h * 520 + j * 260 + idx] = (a.in[I_RELB][bk * 8 + h * 2 + j] - Mb) * LOG2E;
            }
            if (bx == 8 && tid >= 448) {
                const int lane = tid & 63;
                for (int l = 0; l < 2; ++l) { const float* q = a.in[I_LQK] + l * 256;
                    const float s1 = wave_sum(q[lane] * q[64 + lane], lane), s2 = wave_sum(q[128 + lane] * q[192 + lane], lane);
                    const float li = 0.8f - 0.6f * expf(-0.3f * (float)l);
                    if (lane == 0) { miscf[l * 2] = expf(s1) - expf(s2) + li; miscf[l * 2 + 1] = 1.0f - li; } }
            }
        }
    }
    PH_END_FIRST;

#pragma unroll 1
    for (int l = 0; l < 2; ++l) {
        const float* modl = MOD + (size_t)l * 12 * 9216;
        if (PH_IN) {
            if (l == 0) norm_rows<false>(xp, xs, nullptr, a.in[I_NF1] + l * 1024, modl, 0, XN, gw, ngw);
            else norm_rows<true>(nullptr, nullptr, XB, a.in[I_NF1] + l * 1024, modl, 0, XN, gw, ngw);
            for (int rep = 0; rep < REP_CVT; ++rep) convert_weights(a, l, lds, gw, ngw, wave);
        }
        PH_END;
        if (PH_IN) for (int rep = 0; rep < REP_G1; ++rep) { __syncthreads();
            pg8::Gemm g{XN, (const bf16_t*)(WSP + WS_WI1), 1024, 1024, 1024}; pg8::StaticOrder S; S.init(T, 2 * FF, G, bx);
            EpiSwiglu E{ACT}; pg8::gemm_phase(lds, g, S, E); }
        PH_END;
        if (PH_IN) for (int rep = 0; rep < (l == 0 ? REP_G2 : 1); ++rep) { __syncthreads();
            pg8::Gemm g{ACT, (const bf16_t*)(WSP + WS_WO1), FF, FF, FF}; pg8::StaticOrder S; S.init(T, D, G, bx);
            if (l == 0) { EpiResidB<0> E{xp, xs, XB, nullptr, nullptr, modl + 2 * 1024, 0.5f, nullptr, nullptr}; pg8::gemm_phase(lds, g, S, E); }
            else { EpiResidB<1> E{nullptr, nullptr, XB, nullptr, nullptr, modl + 2 * 1024, 0.5f, nullptr, nullptr}; pg8::gemm_phase(lds, g, S, E); } }
        PH_END;
        if (PH_IN) for (int rep = 0; rep < REP_N; ++rep) norm_rows_paired(XB, a.in[I_NMIX] + l * 1024, modl, 3, XN, XFc, XFs, gw, ngw);
        PH_END;
        if (PH_IN) for (int rep = 0; rep < REP_G3; ++rep) { __syncthreads();
            { pg8::Gemm g{XN, (const bf16_t*)(WSP + WS_WQK), 1024, 1024, 1024}; pg8::StaticOrder S; S.init(T, 1024, G, bx);
              EpiQK E{Qb, Kb, a.in[I_QN] + l * 64, a.in[I_KN] + l * 64}; pg8::gemm_phase(lds, g, S, E); }
            { pg8::Gemm g{(const bf16_t*)(WSP + WS_WVF), XN, 1024, 1024, 1024}; pg8::StaticOrder S; S.init(512, T, G, bx);
              EpiVF E{VT}; pg8::gemm_phase(lds, g, S, E); }
            { pg8::Gemm g{(const bf16_t*)(WSP + WS_WVF) + (size_t)512 * 1024, XFc, 1024, 1024, 1024}; pg8::FoldOrder S{G, bx};
              EpiF E{FTP, FTS}; pg8::gemm_phase(lds, g, S, E); }
            if (bx < 96) { const int tidn = opaque((int)threadIdx.x), bb = bx >> 3, n = (bx & 7) * 64 + (tidn >> 3), kp = tidn & 7;
                const int rowt = bb < 8 ? bb * SEQ_P + SEQ_P / 2 : TP + (bb - 8) * SEQ_S + SEQ_S / 2;
                const u32x4* xr = (const u32x4*)(XN + (size_t)rowt * D) + kp * 16;
                const u32x4* wr_ = (const u32x4*)((const bf16_t*)(WSP + WS_WVF) + (size_t)(512 + n) * 1024) + kp * 16;
                float accn = 0.f;
#pragma unroll
                for (int k = 0; k < 16; ++k) { const u32x4 xv = xr[k], wv = wr_[k];
#pragma unroll
                    for (int e = 0; e < 4; ++e) { accn += __uint_as_float(xv[e] << 16) * __uint_as_float(wv[e] << 16) + __uint_as_float(xv[e] & 0xffff0000u) * __uint_as_float(wv[e] & 0xffff0000u); } }
                { const int ln_ = tidn & 63; accn += shx(accn, 1, ln_); accn += shx(accn, 2, ln_); accn += shx(accn, 4, ln_); }
                if (kp == 0) NY[bb * 512 + n] = accn; }
        }
        PH_END;
        if (PH_IN) {
            const float lam = __builtin_bit_cast(float, __builtin_amdgcn_readfirstlane(__builtin_bit_cast(int, miscf[l * 2]))), oml = __builtin_bit_cast(float, __builtin_amdgcn_readfirstlane(__builtin_bit_cast(int, miscf[l * 2 + 1])));
            LAS int* qw = (LAS int*)(lds + QUEUE_OFF);
            for (int rep = 0; rep < REP_AT; ++rep)
            for (;;) {
                __syncthreads();
                if (threadIdx.x == 0) qw[0] = (int)atomicAdd(ctl + 64 * (l + 1) + 16 * rep, 1u);
                __syncthreads();
                const int it = qw[0];
                if (it >= 1280) break;
                if (it < 512) { const int i2 = it; attn_unit(lds, Qb, Kb, VT, MIX, BT + (size_t)l * 2080, a.in[I_SUBLN] + l * 128, lam, oml, 8 + (i2 >> 7), (i2 >> 5) & 3, i2 & 31); }
                else if (it < 640) { const int f = it - 512, b = f >> 5, rem = f & 31, pm = rem >> 1, pn = rem & 1;
                    pg8::Gemm g{DFT + (size_t)(pm * 256) * 4096, FTS + (size_t)b * 512 * 4096 + (size_t)(pn * 256) * 4096, 4096, 4096, 4096};
                    EpiStore E{MIX + (size_t)(TP + b * SEQ_S + pm * 256) * D + 512 + pn * 256, D, 0.001953125f, NY + (8 + b) * 512 + pn * 256};
                    pg8::gemm_phase(lds, g, pg8::OneUnit{}, E); }
                else if (it < 1152) { const int i2 = it - 640; attn_unit(lds, Qb, Kb, VT, MIX, BT + (size_t)l * 2080, a.in[I_SUBLN] + l * 128, lam, oml, i2 >> 6, (i2 >> 4) & 3, i2 & 15); }
                else { const int i2 = it - 1152, b = i2 >> 4, rem = i2 & 15, pm = rem >> 1, pn = rem & 1;
                    pg8::Gemm g{DFT + (size_t)(pm * 256) * 8192, FTP + (size_t)b * 512 * 2048 + (size_t)(pn * 256) * 2048, 8192, 2048, 2048};
                    EpiStore E{MIX + (size_t)(b * SEQ_P + pm * 256) * D + 512 + pn * 256, D, 0.00276213586400995f, NY + b * 512 + pn * 256};
                    pg8::gemm_phase(lds, g, pg8::OneUnit{}, E); }
            }
        }
        PH_END;
        if (PH_IN) { __syncthreads();
            pg8::Gemm g{MIX, (const bf16_t*)(WSP + WS_WOUT), 1024, 1024, 1024}; pg8::StaticOrder S; S.init(T, D, G, bx);
            EpiResidB<1> E{nullptr, nullptr, XB, nullptr, nullptr, modl + 5 * 1024, 1.0f, nullptr, nullptr}; pg8::gemm_phase(lds, g, S, E); }
        PH_END;
        if (PH_IN) { if (l == 0) norm_rows<true>(nullptr, nullptr, XB, a.in[I_NF2] + l * 1024, modl, 6, XN, gw, ngw);
            else norm_rows<true>(nullptr, nullptr, XB, a.in[I_NF2] + l * 1024, modl, 6, XN, gw, ngw, DFT, XFs); }
        PH_END;
        if (PH_IN) { __syncthreads();
            pg8::Gemm g{XN, (const bf16_t*)(WSP + WS_WI2), 1024, 1024, 1024}; pg8::StaticOrder S; S.init(T, 2 * FF, G, bx);
            EpiSwiglu E{ACT}; pg8::gemm_phase(lds, g, S, E); }
        PH_END;
        if (PH_IN) { __syncthreads();
            pg8::Gemm g{ACT, (const bf16_t*)(WSP + WS_WO2), FF, FF, FF}; pg8::StaticOrder S; S.init(T, D, G, bx);
            if (l == 0) { EpiResidB<1> E{nullptr, nullptr, XB, nullptr, nullptr, modl + 8 * 1024, 0.5f, nullptr, nullptr}; pg8::gemm_phase(lds, g, S, E); }
            else { EpiResidB<2> E{nullptr, nullptr, nullptr, out, out + (size_t)TP * D, modl + 8 * 1024, 0.5f, DFT, XFs}; pg8::gemm_phase(lds, g, S, E); } }
        if (l == 0) PH_END;
    }
}
#undef WSP
#undef ctl
#undef miscf
#undef BT
#undef MOD
#undef XN
#undef MIX
#undef ACT
#undef Qb
#undef Kb
#undef VT
#undef FTS
#undef FTP
#undef XFc
#undef XFs
#undef NY
#undef DFT
#undef xp
#undef xs
#undef out
#undef XB
#undef STG
extern "C" void kernel_launch(void* const* d_in, const int* in_sizes, int n_in, void* d_out, int out_size, void* d_ws, size_t ws_size, hipStream_t stream) {
    static int grid = 0;
    if (grid == 0) {
        if (n_in != 20 || ws_size < WS_END) { fprintf(stderr, "kernel_launch: unexpected n_in %d / ws %zu\n", n_in, ws_size); grid = -1; return; }
        int dev = 0, cus = 0, per_cu = 0;
        hipGetDevice(&dev); hipDeviceGetAttribute(&cus, hipDeviceAttributeMultiprocessorCount, dev);
        hipFuncSetAttribute((const void*)mega_fwd, hipFuncAttributeMaxDynamicSharedMemorySize, LDS_BYTES);
        hipOccupancyMaxActiveBlocksPerMultiprocessor(&per_cu, (const void*)mega_fwd, 512, LDS_BYTES);
        (void)hipGetLastError();
        if (per_cu < 1) { fprintf(stderr, "kernel_launch: occupancy query says %d\n", per_cu); per_cu = 1; }
        grid = cus;
    }
    if (grid < 0) return;
    hipMemsetAsync((char*)d_ws + WS_CTL, 0, CTL_BYTES, stream);
    Args a{};
    for (int i = 0; i < 20; ++i) a.in[i] = (const float*)d_in[i];
    a.out = (float*)d_out; a.ws = (unsigned char*)d_ws; a.ph_lo = 0; a.ph_hi = 21;
    void* args[] = {&a};
    hipError_t e = hipLaunchCooperativeKernel((const void*)mega_fwd, dim3(grid), dim3(512), args, LDS_BYTES, stream);
    if (e != hipSuccess) fprintf(stderr, "cooperative launch failed: %s (grid %d)\n", hipGetErrorString(e), grid);
}
```
